# Optimizing an MI355X kernel written in HIP

```python
import math
import jax, jax.numpy as jnp
from jax import lax
import numpy as np

D_MODEL = 1024
BATCH = 8
SEQ = 2048
DEPTH = 2

GRID_W = 64
CTX_LEN = 256
EPS = 1e-6
Q_BLOCK = 128
ROPE_THETA = 10000.0
F32 = jnp.float32

POOL_WINDOWS = (2, 4, 8, 16)
POOL_GROUP = D_MODEL // 8
POOL_WIDTH = POOL_GROUP * len(POOL_WINDOWS)
DIFF_HEADS = 4
DIFF_HEAD_DIM = 64
DIFF_V_DIM = 2 * DIFF_HEAD_DIM
DIFF_QK_WIDTH = DIFF_HEADS * 2 * DIFF_HEAD_DIM
DIFF_WIDTH = DIFF_HEADS * DIFF_V_DIM
AB_IN_WIDTH = POOL_WIDTH + 2 * DIFF_QK_WIDTH + DIFF_WIDTH
AB_OUT_WIDTH = POOL_WIDTH + DIFF_WIDTH
MLA_HEADS = 16
MLA_NOPE = 64
MLA_ROPE = 32
MLA_QK = MLA_NOPE + MLA_ROPE
MLA_V = 64
MLA_Q_RANK = 384
MLA_KV_RANK = 256
FFN_HIDDEN = -(-(8 * D_MODEL) // (3 * 256)) * 256
N_AB = (DEPTH + 1) // 2
N_MLA = DEPTH // 2

kernel_name = "hybrid_pool_diffattn_mla_prefix_dit"


def rmsnorm(x, g):
    xf = x.astype(F32)
    y = xf * lax.rsqrt(jnp.mean(xf * xf, axis=-1, keepdims=True) + EPS)
    return (y * g.astype(F32)).astype(x.dtype)


def adaln(cond, w, b):
    m = jax.nn.silu(cond) @ w + b
    return jnp.split(m, 6, axis=-1)


def modulate(h, shift, scale):
    return h * (1.0 + scale) + shift


def axial_rope(rows, rot_dim):
    n_freq = rot_dim // 4
    freqs = ROPE_THETA ** (-jnp.arange(n_freq, dtype=F32) / n_freq)
    row = jnp.repeat(jnp.arange(rows, dtype=F32), GRID_W)
    col = jnp.tile(jnp.arange(GRID_W, dtype=F32), rows)
    ang = jnp.concatenate([row[:, None] * freqs, col[:, None] * freqs], axis=-1)
    return jnp.cos(ang), jnp.sin(ang)


def apply_rope(x, cos, sin):
    shp = (cos.shape[0],) + (1,) * (x.ndim - 3) + (cos.shape[1],)
    cs, sn = cos.reshape(shp), sin.reshape(shp)
    xf = x.astype(F32)
    half = x.shape[-1] // 2
    x1, x2 = xf[..., :half], xf[..., half:]
    return jnp.concatenate([x1 * cs - x2 * sn, x1 * sn + x2 * cs], axis=-1).astype(x.dtype)


def sweep_query_blocks(core, q, *kv):
    b, n = q.shape[:2]
    nb = n // Q_BLOCK
    qb = jnp.moveaxis(q.reshape((b, nb, Q_BLOCK) + q.shape[2:]), 1, 0)
    o = lax.map(lambda qi: core(qi, *kv), qb)
    return jnp.moveaxis(o, 0, 1).reshape((b, n) + o.shape[3:])


def attn_core(q, k, v, scale):
    s = jnp.einsum('bqhd,bkhd->bhqk', q.astype(F32), k.astype(F32)) * scale
    p = jax.nn.softmax(s, axis=-1)
    return jnp.einsum('bhqk,bkhe->bqhe', p, v.astype(F32)).astype(v.dtype)


def diff_attn_core(q, k, v, lam, scale):
    s = jnp.einsum('bqhjd,bkhjd->bhjqk', q.astype(F32), k.astype(F32)) * scale
    p = jax.nn.softmax(s, axis=-1)
    pd = p[:, :, 0] - lam * p[:, :, 1]
    return jnp.einsum('bhqk,bkhe->bqhe', pd, v.astype(F32)).astype(v.dtype)


def multiscale_pool(u, pool_w, pool_scale):
    b, n, _ = u.shape
    uf = u.astype(F32)
    cs = jnp.concatenate([jnp.zeros((b, 1, POOL_WIDTH), F32), jnp.cumsum(uf, axis=1)], axis=1)
    t = jnp.arange(n)
    outs = []
    for g, w in enumerate(POOL_WINDOWS):
        lo = jnp.clip(t - w // 2, 0, n)
        hi = jnp.clip(t - w // 2 + w, 0, n)
        sl = slice(g * POOL_GROUP, (g + 1) * POOL_GROUP)
        csg = cs[:, :, sl]
        mean = (csg[:, hi] - csg[:, lo]) / (hi - lo).astype(F32)[None, :, None]
        outs.append(mean - uf[:, :, sl])
    d = jnp.stack(outs, axis=2)
    y = jnp.einsum('blgc,gce->blge', d, pool_w.astype(F32)).reshape(b, n, POOL_WIDTH)
    return (y * pool_scale.astype(F32)).astype(u.dtype)


def pool_diff_mixer(a_lat, a_ctx, w_in, w_out, pool_w, pool_scale, q_g, k_g,
                    lq1, lk1, lq2, lk2, subln_g, lam_init, cos, sin, need_ctx):
    def project(a):
        b, n, _ = a.shape
        p = a @ w_in
        u, q, k, v = jnp.split(p, [POOL_WIDTH, POOL_WIDTH + DIFF_QK_WIDTH,
                                   POOL_WIDTH + 2 * DIFF_QK_WIDTH], axis=-1)
        q = rmsnorm(q.reshape(b, n, DIFF_HEADS, 2, DIFF_HEAD_DIM), q_g)
        k = rmsnorm(k.reshape(b, n, DIFF_HEADS, 2, DIFF_HEAD_DIM), k_g)
        v = v.reshape(b, n, DIFF_HEADS, DIFF_V_DIM)
        return u, q, k, v

    lam = (jnp.exp(jnp.sum(lq1.astype(F32) * lk1.astype(F32)))
           - jnp.exp(jnp.sum(lq2.astype(F32) * lk2.astype(F32))) + lam_init)
    scale = DIFF_HEAD_DIM ** -0.5

    def finish(u, o):
        b, n, _ = u.shape
        o = rmsnorm(o, subln_g) * (1.0 - lam_init)
        mixed = jnp.concatenate([multiscale_pool(u, pool_w, pool_scale),
                                 o.reshape(b, n, DIFF_WIDTH).astype(u.dtype)], axis=-1)
        return mixed @ w_out

    u_l, q_l, k_l, v_l = project(a_lat)
    u_c, q_c, k_c, v_c = project(a_ctx)
    q_l = apply_rope(q_l, cos, sin)
    k_l = apply_rope(k_l, cos, sin)
    k_all = jnp.concatenate([k_c, k_l], axis=1)
    v_all = jnp.concatenate([v_c, v_l], axis=1)
    o_l = sweep_query_blocks(lambda qi, kk, vv: diff_attn_core(qi, kk, vv, lam, scale), q_l, k_all, v_all)
    out_l = finish(u_l, o_l)
    out_c = None
    if need_ctx:
        out_c = finish(u_c, diff_attn_core(q_c, k_c, v_c, lam, scale))
    return out_l, out_c


def mla_mixer(a_lat, a_ctx, w_dq, q_lat_g, w_uq, w_dkv, kv_lat_g, w_ukv,
              q_g, k_g, w_out, cos, sin, need_ctx):
    def keys_values(a):
        b, n, _ = a.shape
        ckv = a @ w_dkv
        c_kv = rmsnorm(ckv[..., :MLA_KV_RANK], kv_lat_g)
        k_rope = ckv[..., MLA_KV_RANK:]
        kvh = (c_kv @ w_ukv).reshape(b, n, MLA_HEADS, MLA_NOPE + MLA_V)
        k = jnp.concatenate([kvh[..., :MLA_NOPE],
                             jnp.broadcast_to(k_rope[:, :, None, :], (b, n, MLA_HEADS, MLA_ROPE))], axis=-1)
        return rmsnorm(k, k_g), kvh[..., MLA_NOPE:]

    def queries(a):
        b, n, _ = a.shape
        q = (rmsnorm(a @ w_dq, q_lat_g) @ w_uq).reshape(b, n, MLA_HEADS, MLA_QK)
        return rmsnorm(q, q_g)

    def rope_tail(t):
        return jnp.concatenate([t[..., :MLA_NOPE], apply_rope(t[..., MLA_NOPE:], cos, sin)], axis=-1)

    scale = MLA_QK ** -0.5
    k_l, v_l = keys_values(a_lat)
    k_c, v_c = keys_values(a_ctx)
    q_l = rope_tail(queries(a_lat))
    k_l = rope_tail(k_l)
    k_all = jnp.concatenate([k_c, k_l], axis=1)
    v_all = jnp.concatenate([v_c, v_l], axis=1)
    b, n, _ = a_lat.shape
    o_l = sweep_query_blocks(lambda qi, kk, vv: attn_core(qi, kk, vv, scale), q_l, k_all, v_all)
    out_l = o_l.reshape(b, n, MLA_HEADS * MLA_V) @ w_out
    out_c = None
    if need_ctx:
        o_c = attn_core(queries(a_ctx), k_c, v_c, scale)
        out_c = o_c.reshape(a_ctx.shape[0], a_ctx.shape[1], MLA_HEADS * MLA_V) @ w_out
    return out_l, out_c


def swiglu(a, wg, wu, wd):
    return (jax.nn.silu(a @ wg) * (a @ wu)) @ wd


def setup_inputs(seed: int = 0) -> dict:
    key = jax.random.key(seed)
    ks = iter(jax.random.split(key, 48))

    def nrm(shape, scale):
        return jax.random.normal(next(ks), shape, F32) * scale

    def gain(shape):
        return 1.0 + 0.1 * jax.random.normal(next(ks), shape, F32)

    D = D_MODEL
    return {
        "x": nrm((BATCH, SEQ, D), 1.0),
        "c": nrm((BATCH, D), 1.0),
        "ctx": nrm((BATCH, CTX_LEN, D), 1.0),
        "c_ctx": nrm((D,), 1.0),
        "mod_w": nrm((DEPTH, D, 6 * D), 0.5 * D ** -0.5),
        "mod_b": nrm((DEPTH, 6 * D), 0.02),
        "norm_mix_g": gain((DEPTH, D)),
        "norm_ffn_g": gain((DEPTH, D)),
        "ffn_w_gate": nrm((DEPTH, D, FFN_HIDDEN), D ** -0.5),
        "ffn_w_up": nrm((DEPTH, D, FFN_HIDDEN), D ** -0.5),
        "ffn_w_down": nrm((DEPTH, FFN_HIDDEN, D), FFN_HIDDEN ** -0.5),
        "ab_w_in": nrm((N_AB, D, AB_IN_WIDTH), D ** -0.5),
        "ab_w_out": nrm((N_AB, AB_OUT_WIDTH, D), AB_OUT_WIDTH ** -0.5),
        "pool_w": nrm((N_AB, len(POOL_WINDOWS), POOL_GROUP, POOL_GROUP), POOL_GROUP ** -0.5),
        "pool_scale": gain((N_AB, POOL_WIDTH)),
        "diff_q_norm_g": gain((N_AB, DIFF_HEAD_DIM)),
        "diff_k_norm_g": gain((N_AB, DIFF_HEAD_DIM)),
        "diff_lam_q1": nrm((N_AB, DIFF_HEAD_DIM), 0.1),
        "diff_lam_k1": nrm((N_AB, DIFF_HEAD_DIM), 0.1),
        "diff_lam_q2": nrm((N_AB, DIFF_HEAD_DIM), 0.1),
        "diff_lam_k2": nrm((N_AB, DIFF_HEAD_DIM), 0.1),
        "diff_subln_g": gain((N_AB, DIFF_V_DIM)),
        "mla_w_dq": nrm((N_MLA, D, MLA_Q_RANK), D ** -0.5),
        "mla_q_lat_g": gain((N_MLA, MLA_Q_RANK)),
        "mla_w_uq": nrm((N_MLA, MLA_Q_RANK, MLA_HEADS * MLA_QK), MLA_Q_RANK ** -0.5),
        "mla_w_dkv": nrm((N_MLA, D, MLA_KV_RANK + MLA_ROPE), D ** -0.5),
        "mla_kv_lat_g": gain((N_MLA, MLA_KV_RANK)),
        "mla_w_ukv": nrm((N_MLA, MLA_KV_RANK, MLA_HEADS * (MLA_NOPE + MLA_V)), MLA_KV_RANK ** -0.5),
        "mla_q_norm_g": gain((N_MLA, MLA_QK)),
        "mla_k_norm_g": gain((N_MLA, MLA_QK)),
        "mla_w_out": nrm((N_MLA, MLA_HEADS * MLA_V, D), (MLA_HEADS * MLA_V) ** -0.5),
    }


def reference(x, c, ctx, c_ctx, mod_w, mod_b, norm_mix_g, norm_ffn_g,
              ffn_w_gate, ffn_w_up, ffn_w_down,
              ab_w_in, ab_w_out, pool_w, pool_scale, diff_q_norm_g, diff_k_norm_g,
              diff_lam_q1, diff_lam_k1, diff_lam_q2, diff_lam_k2, diff_subln_g,
              mla_w_dq, mla_q_lat_g, mla_w_uq, mla_w_dkv, mla_kv_lat_g, mla_w_ukv,
              mla_q_norm_g, mla_k_norm_g, mla_w_out):
    n_lat = x.shape[1]
    rows = n_lat // GRID_W
    cos_d, sin_d = axial_rope(rows, DIFF_HEAD_DIM)
    cos_m, sin_m = axial_rope(rows, MLA_ROPE)
    h, hc = x, ctx
    for layer in range(DEPTH):
        last = layer == DEPTH - 1
        sh1, sc1, g1, sh2, sc2, g2 = adaln(c, mod_w[layer], mod_b[layer])
        csh1, csc1, cg1, csh2, csc2, cg2 = adaln(c_ctx, mod_w[layer], mod_b[layer])
        a_lat = modulate(rmsnorm(h, norm_mix_g[layer]), sh1[:, None], sc1[:, None])
        a_ctx = modulate(rmsnorm(hc, norm_mix_g[layer]), csh1, csc1)
        if layer % 2 == 0:
            i = layer // 2
            lam_init = 0.8 - 0.6 * math.exp(-0.3 * layer)
            m_lat, m_ctx = pool_diff_mixer(
                a_lat, a_ctx, ab_w_in[i], ab_w_out[i], pool_w[i], pool_scale[i],
                diff_q_norm_g[i], diff_k_norm_g[i], diff_lam_q1[i], diff_lam_k1[i],
                diff_lam_q2[i], diff_lam_k2[i], diff_subln_g[i], lam_init,
                cos_d, sin_d, not last)
        else:
            i = layer // 2
            m_lat, m_ctx = mla_mixer(
                a_lat, a_ctx, mla_w_dq[i], mla_q_lat_g[i], mla_w_uq[i], mla_w_dkv[i],
                mla_kv_lat_g[i], mla_w_ukv[i], mla_q_norm_g[i], mla_k_norm_g[i],
                mla_w_out[i], cos_m, sin_m, not last)
        h = h + g1[:, None] * m_lat
        f_lat = modulate(rmsnorm(h, norm_ffn_g[layer]), sh2[:, None], sc2[:, None])
        h = h + g2[:, None] * swiglu(f_lat, ffn_w_gate[layer], ffn_w_up[layer], ffn_w_down[layer])
        if not last:
            hc = hc + cg1 * m_ctx
            f_ctx = modulate(rmsnorm(hc, norm_ffn_g[layer]), csh2, csc2)
            hc = hc + cg2 * swiglu(f_ctx, ffn_w_gate[layer], ffn_w_up[layer], ffn_w_down[layer])
    return h
```

```cpp
#include <hip/hip_runtime.h>
#include <hip/hip_cooperative_groups.h>
#include <cstdio>
#include <cstdint>
namespace cg = cooperative_groups;
namespace pg8 {
#define PG8_LAS __attribute__((address_space(3)))
typedef unsigned short bf16_t;
typedef short bf16x8 __attribute__((ext_vector_type(8)));
typedef float f32x4 __attribute__((ext_vector_type(4)));
typedef unsigned u32x4 __attribute__((ext_vector_type(4)));
constexpr int BM = 256, BK = 64, HALF = 128, HTB = HALF * BK * 2  , STAGE_BYTES = 8 * HTB, NXCD = 8, WGM = 8;

__host__ __device__ __forceinline__ int lds_byte(int r, int c) { const int st = (r >> 4) * 2 + (c >> 5), rr = r & 15, cc = c & 31, ob = rr * 64 + cc * 2; return st * 1024 + (ob ^ (((ob >> 9) & 1) << 5)); }
__host__ __device__ __forceinline__ void stage_rc(int b, int& R, int& C) { const int st = b / 1024, sb = b % 1024, swz = sb ^ (((sb >> 9) & 1) << 5); R = (st >> 1) * 16 + swz / 64; C = (st & 1) * 32 + (swz % 64) / 2; }
__host__ __device__ __forceinline__ int perm32(int rho) { const int n = rho >> 4, i = rho & 15; return 8 * (i >> 2) + 4 * n + (i & 3); }

struct Unit { int pm, pn; };
struct Gemm { const bf16_t* A; const bf16_t* Bt; int M, N, K, lda; };

struct StaticOrder {
    int nM, nN, nwg, G, c;
    __host__ __device__ void init(int M, int N, int G_, int c_) { nM = M / BM; nN = N / BM; nwg = nM * nN; G = G_; c = c_; }
    __host__ __device__ bool next(int i, Unit& u) const {
        const long L = (long)i * G + c; if (L >= nwg) return false;
        int wgid = (int)L; { const int q = nwg / NXCD, r = nwg % NXCD, xcd = wgid % NXCD, off = wgid / NXCD; wgid = (xcd < r ? xcd * (q + 1) : r * (q + 1) + (xcd - r) * q) + off; }
        const int nig = WGM * nN, gid = wgid / nig, fm = gid * WGM, gsz = (nM - fm) < WGM ? (nM - fm) : WGM;
        u.pm = fm + ((wgid % nig) % gsz); u.pn = (wgid % nig) / gsz; return true;
    }
    __device__ __forceinline__ void a_ready(const Unit&) const {}
    __device__ __forceinline__ void done(const Unit&) const {}
};
__device__ __forceinline__ unsigned cvt_pk_bf16(float lo, float hi) { unsigned r; asm volatile("v_cvt_pk_bf16_f32 %0, %1, %2" : "=v"(r) : "v"(lo), "v"(hi)); return r; }
template <class Epi, class Sched, bool ALIGN_EPI = false, bool SP2 = false>
__device__ __forceinline__ void gemm_phase(PG8_LAS unsigned char* lds, const Gemm g, const Sched& S, const Epi& E) {
    const int tid = threadIdx.x, wid = __builtin_amdgcn_readfirstlane(tid >> 6), lane = tid & 63, wr = wid >> 2, wc = wid & 3, fr = lane & 15, fq = lane >> 4;
    const int K = g.K, nt = K / BK;
    unsigned voffA[2], voffB[2];
#pragma unroll
    for (int i = 0; i < 2; ++i) { int R, C; stage_rc(tid * 16 + i * 8192, R, C); const int Rb = Epi::PERM ? ((R & ~31) + perm32(R & 31)) : R;
        voffA[i] = (unsigned)(R * g.lda + C) * 2u; voffB[i] = (unsigned)(Rb * K + C) * 2u; }
    const size_t kstep = (size_t)(BK * 2);
    const size_t hstepB = (size_t)HALF * K * 2, hstepA = (size_t)HALF * g.lda * 2;
    const size_t tstepA = 2 * hstepA, tstepB = 2 * hstepB;
    const unsigned ldsw = (unsigned)wid * 1024u;
    const int aoff = lds_byte(wr * 64 + fr, fq * 8), boff = lds_byte(wc * 32 + fr, fq * 8);
#define PG8_SA(b, h) (((b) * 2 + (h)) * HTB)
#define PG8_SB(b, h) ((4 + (b) * 2 + (h)) * HTB)
#define PG8_STAGE(bufoff, gbase, voff) do { _Pragma("unroll") for (int _i = 0; _i < 2; ++_i) \
        __builtin_amdgcn_global_load_lds((const unsigned*)((const char*)(gbase) + (voff)[_i]), (PG8_LAS unsigned*)(lds + (bufoff) + ldsw + _i * 8192), 16, 0, 0); } while (0)
#define PG8_LDA(dst, b, h) do { _Pragma("unroll") for (int m = 0; m < 4; ++m) _Pragma("unroll") for (int k = 0; k < 2; ++k) dst[m][k] = *(const PG8_LAS bf16x8*)(lds + PG8_SA(b, h) + aoff + m * 2048 + k * 1024); } while (0)
#define PG8_LDB(dst, b, h) do { _Pragma("unroll") for (int n = 0; n < 2; ++n) _Pragma("unroll") for (int k = 0; k < 2; ++k) dst[n][k] = *(const PG8_LAS bf16x8*)(lds + PG8_SB(b, h) + boff + n * 2048 + k * 1024); } while (0)
#define PG8_MMA(ai, bj, At, Bt) do { __builtin_amdgcn_s_setprio(1); _Pragma("unroll") for (int m = 0; m < 4; ++m) _Pragma("unroll") for (int n = 0; n < 2; ++n) _Pragma("unroll") for (int k = 0; k < 2; ++k) \
        acc[ai][bj][m][n] = __builtin_amdgcn_mfma_f32_16x16x32_bf16(Bt[n][k], At[m][k], acc[ai][bj][m][n], 0, 0, 0); __builtin_amdgcn_s_setprio(0); } while (0)
#define PG8_WAIT_V(n) asm volatile("s_waitcnt vmcnt(" #n ")" ::: "memory")
#define PG8_WAIT_L(n) asm volatile("s_waitcnt lgkmcnt(" #n ")" ::: "memory")
#define PG8_BAR __builtin_amdgcn_s_barrier()
#define PG8_SCHED __builtin_amdgcn_sched_barrier(0)
    Unit cur, nxt; int ui = 0;
    if (!S.next(0, cur)) return;
    f32x4 acc[2][2][4][2];
#pragma unroll
    for (int a = 0; a < 2; ++a)
#pragma unroll
        for (int b = 0; b < 2; ++b)
#pragma unroll
            for (int m = 0; m < 4; ++m)
#pragma unroll
                for (int n = 0; n < 2; ++n) acc[a][b][m][n] = (f32x4){0.f, 0.f, 0.f, 0.f};
    bf16x8 At[4][2], B0[2][2], B1[2][2];
    const char* cA = (const char*)g.A + (size_t)cur.pm * tstepA; const char* cB = (const char*)g.Bt + (size_t)cur.pn * tstepB;
    S.a_ready(cur);
    if constexpr (SP2) {
        PG8_STAGE(PG8_SB(0, 0), cB, voffB); PG8_STAGE(PG8_SB(0, 1), cB + hstepB, voffB); PG8_STAGE(PG8_SA(0, 0), cA, voffA); PG8_STAGE(PG8_SA(0, 1), cA + hstepA, voffA);
        if (wr == 1) PG8_BAR;
        PG8_WAIT_V(2); PG8_BAR;
        PG8_STAGE(PG8_SB(1, 0), cB + kstep, voffB); PG8_STAGE(PG8_SA(1, 0), cA + kstep, voffA); PG8_STAGE(PG8_SB(1, 1), cB + hstepB + kstep, voffB);
        PG8_WAIT_V(6); PG8_BAR;
    } else {
        PG8_STAGE(PG8_SB(0, 0), cB, voffB); PG8_STAGE(PG8_SA(0, 0), cA, voffA); PG8_STAGE(PG8_SB(0, 1), cB + hstepB, voffB); PG8_STAGE(PG8_SA(0, 1), cA + hstepA, voffA);
        if (wr == 1) PG8_BAR;
        PG8_WAIT_V(4); PG8_BAR;
        PG8_STAGE(PG8_SB(1, 0), cB + kstep, voffB); PG8_STAGE(PG8_SA(1, 0), cA + kstep, voffA); PG8_STAGE(PG8_SB(1, 1), cB + hstepB + kstep, voffB);
        PG8_WAIT_V(6); PG8_BAR;
    }
    for (;;) {
        const bool has_next = S.next(ui + 1, nxt);
        const char* nA = has_next ? (const char*)g.A + (size_t)nxt.pm * tstepA : cA; const char* nB = has_next ? (const char*)g.Bt + (size_t)nxt.pn * tstepB : cB;
        for (int t = 0; t < nt; t += 2) {
            const bool last = (t == nt - 2);
            const char* a1 = cA + (size_t)(t + 1) * kstep;
            const char* a2 = last ? nA : cA + (size_t)(t + 2) * kstep; const char* b2 = last ? nB : cB + (size_t)(t + 2) * kstep;
            const char* a3 = a2 + kstep; const char* b3 = b2 + kstep;
            if (last && has_next) S.a_ready(nxt);
            if constexpr (SP2) {
            PG8_LDB(B0, 0, 0); PG8_LDB(B1, 0, 1); PG8_SCHED; PG8_LDA(At, 0, 0); PG8_STAGE(PG8_SA(1, 1), a1 + hstepA, voffA);
            PG8_WAIT_V(8); PG8_WAIT_L(0); PG8_BAR; PG8_MMA(0, 0, At, B0); PG8_MMA(0, 1, At, B1); PG8_BAR; PG8_SCHED;
            PG8_LDA(At, 0, 1); PG8_STAGE(PG8_SB(0, 0), b2, voffB); PG8_STAGE(PG8_SB(0, 1), b2 + hstepB, voffB); PG8_STAGE(PG8_SA(0, 0), a2, voffA);
            PG8_WAIT_V(8); PG8_WAIT_L(0); PG8_BAR; PG8_MMA(1, 0, At, B0); PG8_MMA(1, 1, At, B1); PG8_BAR; PG8_SCHED;
            PG8_LDB(B0, 1, 0); PG8_LDB(B1, 1, 1); PG8_SCHED; PG8_LDA(At, 1, 0); PG8_STAGE(PG8_SA(0, 1), a2 + hstepA, voffA);
            PG8_WAIT_V(8); PG8_WAIT_L(0); PG8_BAR; PG8_MMA(0, 0, At, B0); PG8_MMA(0, 1, At, B1); PG8_BAR; PG8_SCHED;
            PG8_LDA(At, 1, 1); PG8_STAGE(PG8_SB(1, 0), b3, voffB); PG8_STAGE(PG8_SB(1, 1), b3 + hstepB, voffB); PG8_STAGE(PG8_SA(1, 0), a3, voffA);
            PG8_WAIT_V(8); PG8_WAIT_L(0); PG8_BAR; PG8_MMA(1, 0, At, B0); PG8_MMA(1, 1, At, B1); PG8_BAR; PG8_SCHED;
            } else {
            PG8_LDB(B0, 0, 0); PG8_SCHED; PG8_LDA(At, 0, 0); PG8_STAGE(PG8_SA(1, 1), a1 + hstepA, voffA);
            PG8_WAIT_L(8); PG8_BAR; PG8_WAIT_L(0); PG8_MMA(0, 0, At, B0); PG8_BAR; PG8_SCHED;
            PG8_LDB(B1, 0, 1); PG8_STAGE(PG8_SB(0, 0), b2, voffB);
            PG8_BAR; PG8_WAIT_L(0); PG8_MMA(0, 1, At, B1); PG8_BAR;
            PG8_LDA(At, 0, 1); PG8_STAGE(PG8_SA(0, 0), a2, voffA);
            PG8_BAR; PG8_WAIT_L(0); PG8_MMA(1, 0, At, B0); PG8_BAR; PG8_SCHED;
            PG8_STAGE(PG8_SB(0, 1), b2 + hstepB, voffB);
            PG8_WAIT_V(6); PG8_BAR; PG8_MMA(1, 1, At, B1); PG8_BAR;
            PG8_LDB(B0, 1, 0); PG8_SCHED; PG8_LDA(At, 1, 0); PG8_STAGE(PG8_SA(0, 1), a2 + hstepA, voffA);
            PG8_WAIT_L(8); PG8_BAR; PG8_WAIT_L(0); PG8_MMA(0, 0, At, B0); PG8_BAR; PG8_SCHED;
            PG8_LDB(B1, 1, 1); PG8_STAGE(PG8_SB(1, 0), b3, voffB);
            PG8_BAR; PG8_WAIT_L(0); PG8_MMA(0, 1, At, B1); PG8_BAR;
            PG8_LDA(At, 1, 1); PG8_STAGE(PG8_SA(1, 0), a3, voffA);
            PG8_BAR; PG8_WAIT_L(0); PG8_MMA(1, 0, At, B0); PG8_BAR; PG8_SCHED;
            PG8_STAGE(PG8_SB(1, 1), b3 + hstepB, voffB);
            PG8_WAIT_V(6); PG8_BAR; PG8_MMA(1, 1, At, B1); PG8_BAR;
            }
        }
        if constexpr (ALIGN_EPI) { if (wr == 0) PG8_BAR; }
        if constexpr (!Epi::AFTER_DRAIN) { E(acc, cur, wr, wc, fr, fq); S.done(cur); }
        if (!has_next) break;
#pragma unroll
        for (int a = 0; a < 2; ++a)
#pragma unroll
            for (int b = 0; b < 2; ++b)
#pragma unroll
                for (int m = 0; m < 4; ++m)
#pragma unroll
                    for (int n = 0; n < 2; ++n) acc[a][b][m][n] = (f32x4){0.f, 0.f, 0.f, 0.f};
        cur = nxt; cA = nA; cB = nB; ++ui;
        if constexpr (ALIGN_EPI) { if (wr == 1) PG8_BAR; }
    }
    PG8_WAIT_V(0);
    if constexpr (!ALIGN_EPI) { if (wr == 0) PG8_BAR; }
    PG8_BAR;
    if constexpr (Epi::AFTER_DRAIN) { E.fused(acc, cur, wr, wc, fr, fq, lds, wid, lane); S.done(cur); }
#undef PG8_SA
#undef PG8_SB
#undef PG8_STAGE
#undef PG8_LDA
#undef PG8_LDB
#undef PG8_MMA
#undef PG8_WAIT_V
#undef PG8_WAIT_L
#undef PG8_BAR
#undef PG8_SCHED
}
}
using pg8::bf16_t; using pg8::bf16x8; using pg8::f32x4; using pg8::cvt_pk_bf16; using pg8::Unit;
#define LAS __attribute__((address_space(3)))
typedef unsigned u32x2 __attribute__((ext_vector_type(2)));
typedef unsigned u32x4 __attribute__((ext_vector_type(4)));
typedef short s16x4 __attribute__((ext_vector_type(4)));

#ifndef ONE_LAUNCH
#define ONE_LAUNCH 1
#endif
constexpr int NTHR = 512;
constexpr int DM = 1024, NB = 8, SEQ = 2048, CTX = 256, MLAT = NB * SEQ, MCTX = NB * CTX, MTOT = MLAT + MCTX;
constexpr int FFN = 2816, NKEY = CTX + SEQ;
constexpr float EPS = 1e-6f;
constexpr float LOG2E = 1.4426950408889634f;
constexpr float LOG2_THETA = 13.287712379549449f;
constexpr float LAM_INIT0 = 0.2f;

constexpr size_t WS_MOD   = 0;
constexpr size_t WS_WIN   = 442368;
constexpr size_t WS_WOUT  = WS_WIN   + (size_t)2048 * 1024 * 2;
constexpr size_t WS_WGU0  = WS_WOUT  + (size_t)1024 * 1024 * 2;
constexpr size_t WS_WGU1  = WS_WGU0  + (size_t)5632 * 1024 * 2;
constexpr size_t WS_WD0   = WS_WGU1  + (size_t)5632 * 1024 * 2;
constexpr size_t WS_WD1   = WS_WD0   + (size_t)1024 * 2816 * 2;
constexpr size_t WS_WDQKV = WS_WD1   + (size_t)1024 * 2816 * 2;
constexpr size_t WS_WUQ   = WS_WDQKV + (size_t)768 * 1024 * 2;
constexpr size_t WS_WUKV  = WS_WUQ   + (size_t)1536 * 384 * 2;
constexpr size_t WS_WMO   = WS_WUKV  + (size_t)2048 * 256 * 2;
constexpr size_t WS_HC    = WS_WMO   + (size_t)1024 * 1024 * 2;
constexpr size_t WS_A     = WS_HC    + (size_t)MCTX * 1024 * 4;
constexpr size_t WS_ARENA = WS_A     + (size_t)MTOT * 1024 * 2;
constexpr size_t WS_P     = WS_ARENA;
constexpr size_t WS_MIX   = WS_P     + (size_t)MTOT * 2048 * 2;
constexpr size_t WS_HID   = WS_ARENA;
constexpr size_t WS_HIDC  = WS_HID   + (size_t)MLAT * FFN * 2;
constexpr size_t WS_WD0S  = WS_ARENA + (size_t)120 * 1024 * 1024;
constexpr size_t WS_PART  = WS_ARENA + (size_t)132 * 1024 * 1024;
constexpr size_t WS_CQKV  = WS_ARENA;
constexpr size_t WS_QRAW  = WS_CQKV  + (size_t)MTOT * 768 * 2;
constexpr size_t WS_KVRAW = WS_QRAW  + (size_t)MLAT * 1536 * 2;
constexpr size_t WS_KRN   = WS_KVRAW + (size_t)MTOT * 2048 * 2;
constexpr size_t WS_END   = WS_KRN   + (size_t)MTOT * 512 * 2;
static_assert(WS_END <= (size_t)256 * 1024 * 1024, "workspace too large");
constexpr size_t WS_BAR   = (WS_END + 255) & ~(size_t)255;
constexpr size_t WS_SS    = WS_BAR + 16384;
constexpr size_t ZERO_BYTES = 16384 + (size_t)2 * MTOT * 4;
static_assert(WS_HID + (size_t)MTOT * FFN * 2 <= WS_WD0S && WS_MIX + (size_t)MTOT * 1024 * 2 <= WS_WD0S && WS_WD0S + (size_t)FFN * 1024 * 2 <= WS_PART && WS_PART + (size_t)4 * MCTX * 1024 * 4 <= WS_BAR, "layer-0 split buffers overlap");
static_assert(WS_MIX + (size_t)MTOT * 1024 * 2 <= (size_t)256 * 1024 * 1024, "workspace too large");
static_assert(WS_HID + (size_t)MTOT * FFN * 2 <= (size_t)256 * 1024 * 1024, "workspace too large");

struct Params { const float* in[31]; float* out; unsigned char* ws; int ph_lo, ph_hi; };

__device__ __forceinline__ float bf2f(unsigned short v) { return __uint_as_float((unsigned)v << 16); }
__device__ __forceinline__ void unpack8(const u32x4 w, float (&x)[8]) {
#pragma unroll
    for (int i = 0; i < 4; ++i) { x[2 * i] = __uint_as_float(w[i] << 16); x[2 * i + 1] = __uint_as_float(w[i] & 0xffff0000u); }
}
__device__ __forceinline__ u32x4 pack8(const float (&x)[8]) {
    u32x4 w; w.x = cvt_pk_bf16(x[0], x[1]); w.y = cvt_pk_bf16(x[2], x[3]); w.z = cvt_pk_bf16(x[4], x[5]); w.w = cvt_pk_bf16(x[6], x[7]); return w;
}
template <int CTRL> __device__ __forceinline__ float dpp_f(float v) { return __uint_as_float((unsigned)__builtin_amdgcn_update_dpp(0, (int)__float_as_uint(v), CTRL, 0xF, 0xF, true)); }
__device__ __forceinline__ float sum_x1(float v) { return v + dpp_f<0xB1>(v); }
__device__ __forceinline__ float sum_x2(float v) { return v + dpp_f<0x4E>(v); }
__device__ __forceinline__ float sum_x4(float v) { return v + dpp_f<0x141>(v); }
__device__ __forceinline__ float sum_x8(float v) { return v + dpp_f<0x140>(v); }
__device__ __forceinline__ float sum_x16(float v) { const auto r = __builtin_amdgcn_permlane16_swap(__float_as_uint(v), __float_as_uint(v), false, false); return __uint_as_float(r[0]) + __uint_as_float(r[1]); }
__device__ __forceinline__ float sum_x32(float v) { const auto r = __builtin_amdgcn_permlane32_swap(__float_as_uint(v), __float_as_uint(v), false, false); return __uint_as_float(r[0]) + __uint_as_float(r[1]); }
__device__ __forceinline__ float wave_sum(float v) { return sum_x32(sum_x16(sum_x8(sum_x4(sum_x2(sum_x1(v)))))); }
__device__ __forceinline__ float silu_f(float g) { return g * __builtin_amdgcn_rcpf(1.0f + __expf(-g)); }
__device__ __forceinline__ float rope_freq(int f, float inv_n) { return __builtin_amdgcn_exp2f(-(float)f * inv_n * LOG2_THETA); }
__device__ __forceinline__ void fast_sincos(float ang, float& sn, float& cs) {
    float rev = ang * 0.15915494309189535f; rev = rev - floorf(rev);
    sn = __builtin_amdgcn_sinf(rev); cs = __builtin_amdgcn_cosf(rev);
}

struct EpiStoreBf16 {
    static constexpr bool PERM = true, AFTER_DRAIN = false;
    bf16_t* O; int ldc; const float* ss; float invn;
    __device__ __forceinline__ void operator()(const f32x4 (&acc)[2][2][4][2], const Unit& u, int wr, int wc, int fr, int fq) const {
        const int row0 = u.pm * 256 + wr * 64 + fr, col0 = u.pn * 256 + wc * 32 + 8 * fq;
#pragma unroll
        for (int ai = 0; ai < 2; ++ai)
#pragma unroll
            for (int m = 0; m < 4; ++m) { const int row = row0 + ai * 128 + m * 16; bf16_t* rowp = O + (size_t)row * ldc + col0;
                const float sc = ss ? rsqrtf(ss[row] * invn + EPS) : 1.0f;
#pragma unroll
                for (int bj = 0; bj < 2; ++bj) { const f32x4 v0 = acc[ai][bj][m][0] * sc, v1 = acc[ai][bj][m][1] * sc; u32x4 w;
                    w.x = cvt_pk_bf16(v0[0], v0[1]); w.y = cvt_pk_bf16(v0[2], v0[3]); w.z = cvt_pk_bf16(v1[0], v1[1]); w.w = cvt_pk_bf16(v1[2], v1[3]);
                    *(u32x4*)(rowp + bj * 128) = w; } }
    }
};
struct EpiLat {
    static constexpr bool PERM = true, AFTER_DRAIN = false;
    bf16_t* O; const float* gq; const float* gkv; float* ssq; float* ssk;
    __device__ __forceinline__ void operator()(const f32x4 (&acc)[2][2][4][2], const Unit& u, int wr, int wc, int fr, int fq) const {
        const int row0 = u.pm * 256 + wr * 64 + fr;
#pragma unroll
        for (int bj = 0; bj < 2; ++bj) {
            const int half = u.pn * 2 + bj;
            const int col0 = half * 128 + wc * 32 + 8 * fq;
            f32x4 g0 = {1.f, 1.f, 1.f, 1.f}, g1 = {1.f, 1.f, 1.f, 1.f};
            if (half < 3) { g0 = *(const f32x4*)(gq + col0); g1 = *(const f32x4*)(gq + col0 + 4); }
            else if (half < 5) { g0 = *(const f32x4*)(gkv + col0 - 384); g1 = *(const f32x4*)(gkv + col0 - 380); }
            float* sp = half < 3 ? ssq : ssk;
#pragma unroll
            for (int ai = 0; ai < 2; ++ai)
#pragma unroll
                for (int m = 0; m < 4; ++m) { const int row = row0 + ai * 128 + m * 16;
                    const f32x4 r0 = acc[ai][bj][m][0], r1 = acc[ai][bj][m][1];
                    float s2 = (r0[0] * r0[0] + r0[1] * r0[1]) + (r0[2] * r0[2] + r0[3] * r0[3]) + (r1[0] * r1[0] + r1[1] * r1[1]) + (r1[2] * r1[2] + r1[3] * r1[3]);
                    s2 = sum_x32(sum_x16(s2));
                    if (half < 5 && fq == 0) (void)__hip_atomic_fetch_add(sp + row, s2, __ATOMIC_RELAXED, __HIP_MEMORY_SCOPE_AGENT);
                    const f32x4 v0 = r0 * g0, v1 = r1 * g1; u32x4 w;
                    w.x = cvt_pk_bf16(v0[0], v0[1]); w.y = cvt_pk_bf16(v0[2], v0[3]); w.z = cvt_pk_bf16(v1[0], v1[1]); w.w = cvt_pk_bf16(v1[2], v1[3]);
                    *(u32x4*)(O + (size_t)row * 768 + col0) = w; }
        }
    }
};
struct EpiKV {
    static constexpr bool PERM = true, AFTER_DRAIN = false;
    bf16_t* KV; bf16_t* KR; const bf16_t* C; const float* ssk; const float* kg;
    __device__ __forceinline__ void operator()(const f32x4 (&acc)[2][2][4][2], const Unit& u, int wr, int wc, int fr_, int fq_) const {
        int fr = fr_, fq = fq_; asm volatile("" : "+v"(fr), "+v"(fq));
        const int row0 = u.pm * 256 + wr * 64 + fr, hh = u.pn * 2 + (wc & 1);
        if (wc < 2) {
            constexpr float fr8[8] = {1.0f, 0.31622776601683794f, 0.1f, 0.031622776601683794f, 0.01f, 0.0031622776601683794f, 0.001f, 0.00031622776601683794f};
            const float* kgn = kg + 8 * fq; const float* kgr = kg + 64 + (fq & 1) * 8;
#pragma unroll
            for (int ai = 0; ai < 2; ++ai)
#pragma unroll
                for (int m = 0; m < 4; ++m) { int row = row0 + ai * 128 + m * 16; asm volatile("" : "+v"(row));
                    int z = 0; asm volatile("" : "+v"(z));
                    f32x4 g[2][2]; float gr1[8], gr2[8];
#pragma unroll
                    for (int bj = 0; bj < 2; ++bj)
#pragma unroll
                        for (int n = 0; n < 2; ++n) g[bj][n] = *(const f32x4*)(kgn + z + bj * 32 + 4 * n);
                    { const f32x4 a = *(const f32x4*)(kgr + z), b = *(const f32x4*)(kgr + z + 4), c = *(const f32x4*)(kgr + z + 16), d = *(const f32x4*)(kgr + z + 20);
#pragma unroll
                      for (int e = 0; e < 4; ++e) { gr1[e] = a[e]; gr1[4 + e] = b[e]; gr2[e] = c[e]; gr2[4 + e] = d[e]; } }
                    const float rk = rsqrtf(ssk[row] * (1.0f / 256.0f) + EPS);
                    const bf16_t* rp = C + (size_t)row * 768 + 640 + (fq & 1) * 8;
                    float x1[8], x2[8]; unpack8(*(const u32x4*)rp, x1); unpack8(*(const u32x4*)(rp + 16), x2);
                    f32x4 v[2][2]; float ss = 0.f, sr = 0.f;
#pragma unroll
                    for (int bj = 0; bj < 2; ++bj)
#pragma unroll
                        for (int n = 0; n < 2; ++n) { v[bj][n] = acc[ai][bj][m][n] * rk; ss += (v[bj][n][0] * v[bj][n][0] + v[bj][n][1] * v[bj][n][1]) + (v[bj][n][2] * v[bj][n][2] + v[bj][n][3] * v[bj][n][3]); }
#pragma unroll
                    for (int e = 0; e < 8; ++e) sr += x1[e] * x1[e] + x2[e] * x2[e];
                    ss = sum_x32(sum_x16(ss)); sr = sum_x16(sr);
                    const float rstd = rsqrtf((ss + sr) * (1.0f / 96.0f) + EPS);
                    bf16_t* kp = KV + (size_t)row * 2048 + hh * 128 + 8 * fq;
#pragma unroll
                    for (int bj = 0; bj < 2; ++bj) { const f32x4 a = v[bj][0] * rstd * g[bj][0], b = v[bj][1] * rstd * g[bj][1]; u32x4 w;
                        w.x = cvt_pk_bf16(a[0], a[1]); w.y = cvt_pk_bf16(a[2], a[3]); w.z = cvt_pk_bf16(b[0], b[1]); w.w = cvt_pk_bf16(b[2], b[3]);
                        *(u32x4*)(kp + bj * 32) = w; }
                    const bool lat = row < MLAT; const int t = row & 2047; const float pos = (fq & 1) ? (float)(t & 63) : (float)(t >> 6);
                    float outv[8];
#pragma unroll
                    for (int e = 0; e < 8; ++e) { const float y1 = x1[e] * rstd * gr1[e], y2 = x2[e] * rstd * gr2[e]; float sn = 0.f, cs = 1.f;
                        if (lat) fast_sincos(pos * fr8[e], sn, cs);
                        outv[e] = (fq & 2) ? (y1 * sn + y2 * cs) : (y1 * cs - y2 * sn); }
                    *(u32x4*)(KR + (size_t)row * 512 + hh * 32 + fq * 8) = pack8(outv);
                    if (m & 1) asm volatile("" ::: "memory"); }
        } else {
#pragma unroll
            for (int ai = 0; ai < 2; ++ai)
#pragma unroll
                for (int m = 0; m < 4; ++m) { int row = row0 + ai * 128 + m * 16; asm volatile("" : "+v"(row));
                    const float rk = rsqrtf(ssk[row] * (1.0f / 256.0f) + EPS);
                    bf16_t* vp = KV + (size_t)row * 2048 + hh * 128 + 64 + 8 * fq;
#pragma unroll
                    for (int bj = 0; bj < 2; ++bj) { const f32x4 a = acc[ai][bj][m][0] * rk, b = acc[ai][bj][m][1] * rk; u32x4 w;
                        w.x = cvt_pk_bf16(a[0], a[1]); w.y = cvt_pk_bf16(a[2], a[3]); w.z = cvt_pk_bf16(b[0], b[1]); w.w = cvt_pk_bf16(b[2], b[3]);
                        *(u32x4*)(vp + bj * 32) = w; } }
        }
    }
};
struct EpiResid {
    static constexpr bool PERM = true, AFTER_DRAIN = false;
    const float* baseL; const float* baseC; float* outL; float* outC; const float* gate;
    __device__ __forceinline__ void operator()(const f32x4 (&acc)[2][2][4][2], const Unit& u, int wr, int wc, int fr, int fq) const {
        const int trow = u.pm * 256; const bool lat = trow < MLAT;
        const float* base = lat ? baseL + (size_t)trow * 1024 : baseC + (size_t)(trow - MLAT) * 1024;
        float* out = lat ? outL + (size_t)trow * 1024 : outC + (size_t)(trow - MLAT) * 1024;
        const float* gp = gate + (size_t)(lat ? (trow >> 11) : 8) * 6144;
        const int r0 = wr * 64 + fr, col0 = u.pn * 256 + wc * 32 + 8 * fq;
        f32x4 gv[2][2];
#pragma unroll
        for (int bj = 0; bj < 2; ++bj)
#pragma unroll
            for (int n = 0; n < 2; ++n) gv[bj][n] = *(const f32x4*)(gp + col0 + bj * 128 + n * 4);
#pragma unroll
        for (int ai = 0; ai < 2; ++ai)
#pragma unroll
            for (int m = 0; m < 4; ++m) { const size_t off = (size_t)(r0 + ai * 128 + m * 16) * 1024 + col0;
#pragma unroll
                for (int bj = 0; bj < 2; ++bj)
#pragma unroll
                    for (int n = 0; n < 2; ++n) { const f32x4 b = *(const f32x4*)(base + off + bj * 128 + n * 4);
                        *(f32x4*)(out + off + bj * 128 + n * 4) = b + gv[bj][n] * acc[ai][bj][m][n]; } }
    }
};
struct EpiSwiglu {
    static constexpr bool PERM = true, AFTER_DRAIN = false;
    bf16_t* H; bf16_t* Hc;
    __device__ __forceinline__ void operator()(const f32x4 (&acc)[2][2][4][2], const Unit& u, int wr, int wc, int fr, int fq) const {
        const int row0 = u.pm * 256 + wr * 64 + fr, col0 = u.pn * 128 + wc * 32 + 8 * fq;
        bf16_t* base = H + col0; long ldh = FFN; int rsub = 0;
        if (Hc != nullptr && u.pm * 256 >= MLAT) { const int c0 = u.pn * 128; rsub = MLAT;
            if (c0 < 1536) { const int sl = c0 >= 768 ? 1 : 0; ldh = 768; base = Hc + (size_t)sl * MCTX * 768 + (col0 - sl * 768); }
            else { const int sl = c0 >= 2176 ? 1 : 0; ldh = 640; base = Hc + (size_t)2 * MCTX * 768 + (size_t)sl * MCTX * 640 + (col0 - 1536 - sl * 640); } }
#pragma unroll
        for (int ai = 0; ai < 2; ++ai)
#pragma unroll
            for (int m = 0; m < 4; ++m) { bf16_t* rowp = base + (long)(row0 - rsub + ai * 128 + m * 16) * ldh;
                const f32x4 g0 = acc[ai][0][m][0], g1 = acc[ai][0][m][1], u0 = acc[ai][1][m][0], u1 = acc[ai][1][m][1]; u32x4 w;
                w.x = cvt_pk_bf16(silu_f(g0[0]) * u0[0], silu_f(g0[1]) * u0[1]); w.y = cvt_pk_bf16(silu_f(g0[2]) * u0[2], silu_f(g0[3]) * u0[3]);
                w.z = cvt_pk_bf16(silu_f(g1[0]) * u1[0], silu_f(g1[1]) * u1[1]); w.w = cvt_pk_bf16(silu_f(g1[2]) * u1[2], silu_f(g1[3]) * u1[3]);
                *(u32x4*)rowp = w; }
    }
};
struct SplitSched {
    int G, c;
    __device__ __forceinline__ bool next(int i, Unit& u) const {
        const int L = i * G + c; if (L >= 64) return false;
        const int sl = L >> 5, rem = L & 31; u.pm = sl * 8 + (rem & 7); u.pn = sl * 4 + (rem >> 3); return true;
    }
    __device__ __forceinline__ void a_ready(const Unit&) const {}
    __device__ __forceinline__ void done(const Unit&) const {}
};
struct EpiPart {
    static constexpr bool PERM = true, AFTER_DRAIN = false;
    float* part; const float* gate;
    __device__ __forceinline__ void operator()(const f32x4 (&acc)[2][2][4][2], const Unit& u, int wr, int wc, int fr, int fq) const {
        float* out = part + (size_t)(u.pm >> 3) * MCTX * 1024;
        const int r0 = (u.pm & 7) * 256 + wr * 64 + fr, col0 = (u.pn & 3) * 256 + wc * 32 + 8 * fq;
#pragma unroll
        for (int bj = 0; bj < 2; ++bj)
#pragma unroll
            for (int n = 0; n < 2; ++n) { const f32x4 gv = *(const f32x4*)(gate + col0 + bj * 128 + n * 4);
#pragma unroll
                for (int ai = 0; ai < 2; ++ai)
#pragma unroll
                    for (int m = 0; m < 4; ++m) *(f32x4*)(out + (size_t)(r0 + ai * 128 + m * 16) * 1024 + col0 + bj * 128 + n * 4) = gv * acc[ai][bj][m][n]; }
    }
};
template <class Epi>
__device__ __forceinline__ void run_gemm(LAS unsigned char* lds, const bf16_t* A, int lda, const bf16_t* Bt, int M, int N, int K, const Epi& E, int crot = 0) {
    pg8::Gemm g; g.A = A; g.Bt = Bt; g.M = M; g.N = N; g.K = K; g.lda = lda;
    pg8::StaticOrder S; S.init(M, N, (int)gridDim.x, ((int)blockIdx.x + crot) % (int)gridDim.x);
    pg8::gemm_phase<Epi, pg8::StaticOrder, true, true>(lds, g, S, E);
}

__device__ __forceinline__ void adaln_phase(const Params& p, LAS unsigned char* lds, int layer, int gidx, int gsize) {
    LAS float* scond = (LAS float*)lds;
    LAS float* part = (LAS float*)(lds + 9 * 1024 * 4);
    const int tid = threadIdx.x, lane = tid & 63, wid = tid >> 6;
    if (gidx < 0) return;
    const float* c = p.in[1]; const float* cctx = p.in[3]; const float* mw = p.in[4]; const float* mb = p.in[5];
    float* MOD = (float*)(p.ws + WS_MOD);
    if (gidx < 96) {
        for (int i = tid; i < 9 * 1024; i += NTHR) { const int r = i >> 10, k = i & 1023; const float v = r < 8 ? c[r * 1024 + k] : cctx[k]; scond[i] = v / (1.0f + __expf(-v)); }
        __syncthreads();
    }
    for (int u = gidx; u < 96; u += gsize) {
        const int l = layer, n0 = u * 64;
        const float* w = mw + (size_t)l * 1024 * 6144 + n0 + lane;
        float acc[9];
#pragma unroll
        for (int r = 0; r < 9; ++r) acc[r] = 0.f;
#pragma unroll 16
        for (int k = wid * 128; k < wid * 128 + 128; ++k) { const float wv = __builtin_nontemporal_load(w + (size_t)k * 6144);
#pragma unroll
            for (int r = 0; r < 9; ++r) acc[r] += scond[r * 1024 + k] * wv; }
#pragma unroll
        for (int r = 0; r < 9; ++r) part[(wid * 9 + r) * 64 + lane] = acc[r];
        __syncthreads();
        for (int i = tid; i < 576; i += NTHR) { const int r = i >> 6, n = i & 63; float s = mb[l * 6144 + n0 + n];
#pragma unroll
            for (int w8 = 0; w8 < 8; ++w8) s += part[(w8 * 9 + r) * 64 + n];
            MOD[(size_t)(l * 9 + r) * 6144 + n0 + n] = s; }
        __syncthreads();
    }
}
__device__ __forceinline__ void tr_job(const float* src, int K, int N, int lds_, bf16_t* dst, int ldd, int mode, int off, LAS float* tile, int& base, int gidx, int G) {
    const int tid = threadIdx.x;
    if (gidx < 0) return;
    const int tn = (N + 63) >> 6, tk = K >> 6, nt = tn * tk;
    int start = (gidx - base) % G; if (start < 0) start += G;
    const int kk = tid >> 4, nn = (tid & 15) * 4, n = tid >> 3, kc = (tid & 7) * 8;
    for (int t = start; t < nt; t += 2 * G) {
        float4 v[2][2];
#pragma unroll
        for (int q = 0; q < 2; ++q) { const int tq = t + q * G; const bool ok = tq < nt; const int k0 = ok ? (tq / tn) * 64 : 0, n0 = ok ? (tq % tn) * 64 : 0;
#pragma unroll
            for (int h = 0; h < 2; ++h) { v[q][h] = make_float4(0.f, 0.f, 0.f, 0.f);
                if (ok && n0 + nn < N) { const f32x4 t4 = __builtin_nontemporal_load((const f32x4*)(src + (size_t)(k0 + kk + h * 32) * lds_ + n0 + nn)); v[q][h] = make_float4(t4[0], t4[1], t4[2], t4[3]); } } }
#pragma unroll
        for (int q = 0; q < 2; ++q)
#pragma unroll
            for (int h = 0; h < 2; ++h) { LAS float* tp = tile + q * (64 * 65) + (kk + h * 32) * 65 + nn; tp[0] = v[q][h].x; tp[1] = v[q][h].y; tp[2] = v[q][h].z; tp[3] = v[q][h].w; }
        __syncthreads();
#pragma unroll
        for (int q = 0; q < 2; ++q) { const int tq = t + q * G; if (tq >= nt) break; const int k0 = (tq / tn) * 64, n0 = (tq % tn) * 64;
            if (n0 + n < N) { float x[8];
#pragma unroll
                for (int e = 0; e < 8; ++e) x[e] = tile[q * (64 * 65) + (kc + e) * 65 + n];
                const int nn_ = n0 + n; int row = mode == 0 ? nn_ + off : ((nn_ >> 7) * 256 + (nn_ & 127) + off);
                if (mode == 2) { const int head = nn_ >> 7, part = (nn_ >> 6) & 1, d = nn_ & 63;
                    row = (head >> 1) * 256 + (d >> 5) * 128 + ((head & 1) + 2 * part) * 32 + (d & 31); }
                *(u32x4*)(dst + (size_t)row * ldd + k0 + kc) = pack8(x); } }
        __syncthreads();
    }
    base = (base + nt) % G;
}
__device__ __forceinline__ void prep_phase(const Params& p, LAS unsigned char* lds, int part, int gidx, int gsize) {
    if (gidx < 0) return;
    if (part < 2) adaln_phase(p, lds, part, gidx, gsize);
    __syncthreads();
    LAS float* tile = (LAS float*)lds; int base = part < 2 ? 96 % gsize : 0;
    unsigned char* ws = p.ws;
    const int gt = gidx * NTHR + threadIdx.x, GT = gsize * NTHR;
    if (part == 0) {
        tr_job(p.in[11], 1024, 2048, 2048, (bf16_t*)(ws + WS_WIN), 1024, 0, 0, tile, base, gidx, gsize);
    } else if (part == 4) {
        tr_job(p.in[12] + (size_t)512 * 1024, 512, 1024, 1024, (bf16_t*)(ws + WS_WOUT) + 512, 1024, 0, 0, tile, base, gidx, gsize);
        { const float* pw = p.in[13]; const float* ps = p.in[14]; const float* wo = p.in[12]; bf16_t* WoT = (bf16_t*)(ws + WS_WOUT);
          for (int it = gt; it < 4 * 32 * 1024; it += GT) { const int n = it & 1023, gc = it >> 10, g = gc >> 5, c0 = (gc & 31) * 4;
              const float* wop = wo + (size_t)(g * 128) * 1024 + n; const float* psp = ps + g * 128; const float* pwp = pw + (size_t)(g * 128 + c0) * 128;
              float s4[4] = {0.f, 0.f, 0.f, 0.f};
#pragma unroll 1
              for (int e0 = 0; e0 < 128; e0 += 16) { float t[16]; f32x4 a[4][4];
#pragma unroll
                  for (int q = 0; q < 16; ++q) t[q] = wop[(size_t)(e0 + q) * 1024] * psp[e0 + q];
#pragma unroll
                  for (int j = 0; j < 4; ++j)
#pragma unroll
                      for (int q4 = 0; q4 < 4; ++q4) a[j][q4] = *(const f32x4*)(pwp + j * 128 + e0 + q4 * 4);
#pragma unroll
                  for (int j = 0; j < 4; ++j)
#pragma unroll
                      for (int q = 0; q < 16; ++q) s4[j] += a[j][q >> 2][q & 3] * t[q]; }
              u32x2 w; w.x = cvt_pk_bf16(s4[0], s4[1]); w.y = cvt_pk_bf16(s4[2], s4[3]);
              *(u32x2*)(WoT + (size_t)n * 1024 + g * 128 + c0) = w; } }
    } else if (part == 2) {
        tr_job(p.in[8], 1024, FFN, FFN, (bf16_t*)(ws + WS_WGU0), 1024, 1, 0, tile, base, gidx, gsize);
        tr_job(p.in[9], 1024, FFN, FFN, (bf16_t*)(ws + WS_WGU0), 1024, 1, 128, tile, base, gidx, gsize);
        tr_job(p.in[10], FFN, 1024, 1024, (bf16_t*)(ws + WS_WD0), FFN, 0, 0, tile, base, gidx, gsize);
        tr_job(p.in[10], 768, 1024, 1024, (bf16_t*)(ws + WS_WD0S), 768, 0, 0, tile, base, gidx, gsize);
        tr_job(p.in[10] + (size_t)768 * 1024, 768, 1024, 1024, (bf16_t*)(ws + WS_WD0S) + (size_t)1024 * 768, 768, 0, 0, tile, base, gidx, gsize);
        tr_job(p.in[10] + (size_t)1536 * 1024, 640, 1024, 1024, (bf16_t*)(ws + WS_WD0S) + (size_t)2 * 1024 * 768, 640, 0, 0, tile, base, gidx, gsize);
        tr_job(p.in[10] + (size_t)2176 * 1024, 640, 1024, 1024, (bf16_t*)(ws + WS_WD0S) + (size_t)2 * 1024 * 768 + (size_t)1024 * 640, 640, 0, 0, tile, base, gidx, gsize);
    } else {
        tr_job(p.in[8] + (size_t)1024 * FFN, 1024, FFN, FFN, (bf16_t*)(ws + WS_WGU1), 1024, 1, 0, tile, base, gidx, gsize);
        tr_job(p.in[9] + (size_t)1024 * FFN, 1024, FFN, FFN, (bf16_t*)(ws + WS_WGU1), 1024, 1, 128, tile, base, gidx, gsize);
        tr_job(p.in[10] + (size_t)FFN * 1024, FFN, 1024, 1024, (bf16_t*)(ws + WS_WD1), FFN, 0, 0, tile, base, gidx, gsize);
        tr_job(p.in[22], 1024, 384, 384, (bf16_t*)(ws + WS_WDQKV), 1024, 0, 0, tile, base, gidx, gsize);
        tr_job(p.in[25], 1024, 288, 288, (bf16_t*)(ws + WS_WDQKV), 1024, 0, 384, tile, base, gidx, gsize);
        tr_job(p.in[24], 384, 1536, 1536, (bf16_t*)(ws + WS_WUQ), 384, 0, 0, tile, base, gidx, gsize);
        tr_job(p.in[27], 256, 2048, 2048, (bf16_t*)(ws + WS_WUKV), 256, 2, 0, tile, base, gidx, gsize);
        tr_job(p.in[30], 1024, 1024, 1024, (bf16_t*)(ws + WS_WMO), 1024, 0, 0, tile, base, gidx, gsize);
        { u32x4* z = (u32x4*)((bf16_t*)(ws + WS_WDQKV) + (size_t)672 * 1024); const u32x4 zero = {0u, 0u, 0u, 0u};
          for (int i = gt; i < 96 * 1024 / 8; i += GT) z[i] = zero; }
    }
}

__device__ __forceinline__ void norm_phase(const float* __restrict__ srcL, const float* __restrict__ srcC, const float* __restrict__ gn, const float* __restrict__ modl, int csh, int csc, bf16_t* __restrict__ dst, int nrows, const float* __restrict__ part = nullptr, bool nt = false) {
    constexpr int RB = 3;
    const int lane = threadIdx.x & 63, wid = threadIdx.x >> 6, nw = gridDim.x * 8;
    for (int r0 = blockIdx.x * 8 + wid; r0 < nrows; r0 += nw * RB) {
        f32x4 v[RB][4];
#pragma unroll
        for (int u = 0; u < RB; ++u) { int r = r0 + u * nw; r = r < nrows ? r : r0;
            const float* s = r < MLAT ? srcL + (size_t)r * 1024 : srcC + (size_t)(r - MLAT) * 1024;
#pragma unroll
            for (int i = 0; i < 4; ++i) v[u][i] = nt ? __builtin_nontemporal_load((const f32x4*)(s + i * 256 + lane * 4)) : *(const f32x4*)(s + i * 256 + lane * 4);
            if (part != nullptr && r >= MLAT) {
#pragma unroll
                for (int sl = 0; sl < 4; ++sl)
#pragma unroll
                    for (int i = 0; i < 4; ++i) v[u][i] += *(const f32x4*)(part + ((size_t)sl * MCTX + (r - MLAT)) * 1024 + i * 256 + lane * 4); } }
#pragma unroll
        for (int u = 0; u < RB; ++u) { const int r = r0 + u * nw; if (r >= nrows) break;
            float ss = 0.f;
#pragma unroll
            for (int i = 0; i < 4; ++i) ss += v[u][i][0] * v[u][i][0] + v[u][i][1] * v[u][i][1] + v[u][i][2] * v[u][i][2] + v[u][i][3] * v[u][i][3];
            ss = wave_sum(ss);
            const float rstd = rsqrtf(ss * (1.0f / 1024.0f) + EPS);
            const int b = r < MLAT ? (r >> 11) : 8; const float* mp = modl + (size_t)b * 6144;
#pragma unroll
            for (int i = 0; i < 4; ++i) { const int c = i * 256 + lane * 4;
                const f32x4 g4 = *(const f32x4*)(gn + c), sh = *(const f32x4*)(mp + csh * 1024 + c), sc = *(const f32x4*)(mp + csc * 1024 + c);
                const f32x4 y = (v[u][i] * rstd) * g4; const f32x4 a = y * (sc + 1.0f) + sh;
                u32x2 w; w.x = cvt_pk_bf16(a[0], a[1]); w.y = cvt_pk_bf16(a[2], a[3]);
                *(u32x2*)(dst + (size_t)r * 1024 + c) = w; } }
    }
}

__device__ __forceinline__ void prepL0_phase(const Params& p, bool dry) {
    constexpr int RB = 2;
    const int lane = threadIdx.x & 63, wid = threadIdx.x >> 6, nw = gridDim.x * 8;
    bf16_t* P = (bf16_t*)(p.ws + WS_P); bf16_t* MIX = (bf16_t*)(p.ws + WS_MIX);
    const float* kg = p.in[16];
    float kgv[8], fr16[8];
#pragma unroll
    for (int e = 0; e < 8; ++e) { kgv[e] = kg[(lane & 7) * 8 + e]; fr16[e] = rope_freq(((lane & 3) * 8 + e) & 15, 1.0f / 16.0f); }
    const int w = 2 << (lane >> 4);
    for (int r0 = blockIdx.x * 8 + wid; r0 < MTOT; r0 += nw * RB) {
        u32x4 wv[RB][16], kv[RB]; int tt[RB], lo_[RB], hi_[RB];
#pragma unroll
        for (int u = 0; u < RB; ++u) { int r = r0 + u * nw; r = r < MTOT ? r : r0;
            int t, n; if (r < MLAT) { t = r & 2047; n = SEQ; } else { t = (r - MLAT) & 255; n = CTX; }
            const int rowbase = r - t; int lo = t - (w >> 1), hi = lo + w; lo = lo < 0 ? 0 : lo; hi = hi > n ? n : hi;
            tt[u] = t; lo_[u] = lo; hi_[u] = hi;
#pragma unroll
            for (int i = 0; i < 16; ++i) { const int s = t - 8 + i; const bool in = s >= lo && s < hi; const int sc = in ? s : t;
                wv[u][i] = *(const u32x4*)(P + (size_t)(rowbase + sc) * 2048 + lane * 8); }
            kv[u] = *(const u32x4*)(P + (size_t)r * 2048 + 1024 + lane * 8); }
#pragma unroll
        for (int u = 0; u < RB; ++u) { const int r = r0 + u * nw; if (r >= MTOT) break;
            const int t = tt[u]; const bool lat = r < MLAT;
            { float sum[8];
#pragma unroll
              for (int e = 0; e < 8; ++e) sum[e] = 0.f;
#pragma unroll
              for (int i = 0; i < 16; ++i) { const int s = t - 8 + i; const bool in = s >= lo_[u] && s < hi_[u]; float x[8]; unpack8(wv[u][i], x);
#pragma unroll
                  for (int e = 0; e < 8; ++e) sum[e] += in ? x[e] : 0.f; }
              float x[8]; unpack8(wv[u][8], x);
              const float inv = 1.0f / (float)(hi_[u] - lo_[u]);
#pragma unroll
              for (int e = 0; e < 8; ++e) sum[e] = sum[e] * inv - x[e];
              *(u32x4*)(MIX + (size_t)r * 1024 + lane * 8) = pack8(sum); }
            { bf16_t* kp = P + (size_t)r * 2048 + 1024 + lane * 8; float x[8]; unpack8(kv[u], x);
              float ss = 0.f;
#pragma unroll
              for (int e = 0; e < 8; ++e) ss += x[e] * x[e];
              ss = sum_x4(sum_x2(sum_x1(ss)));
              const float rstd = rsqrtf(ss * (1.0f / 64.0f) + EPS);
#pragma unroll
              for (int e = 0; e < 8; ++e) x[e] = x[e] * rstd * kgv[e];
              if (lat) { const float pos = (lane & 2) ? (float)(t & 63) : (float)(t >> 6); const bool hi2 = (lane & 4) != 0;
#pragma unroll
                  for (int e = 0; e < 8; ++e) { const float other = __shfl_xor(x[e], 4); float sn, cs; fast_sincos(pos * fr16[e], sn, cs);
                      x[e] = hi2 ? (other * sn + x[e] * cs) : (x[e] * cs - other * sn); } }
              bf16_t* kd = dry ? (bf16_t*)(p.ws + WS_ARENA + (size_t)120 * 1024 * 1024) + (size_t)r * 512 + lane * 8 : kp;
              *(u32x4*)kd = pack8(x); }
        }
    }
}

#ifndef PROBE_DUP
#define PROBE_DUP -1
#endif
#define ATT_BAR() do { asm volatile("s_waitcnt lgkmcnt(0)" ::: "memory"); __builtin_amdgcn_s_barrier(); asm volatile("" ::: "memory"); } while (0)
struct KVSrc { unsigned ka, kb, v; int lda, offa, ldb, offb, ldv, offv; int ctx_row0, lat_row0; };

template <int DQK, int DV, int CA, bool PAIR>
struct AttnCore {
    static constexpr int KW = PAIR ? 2 * DQK : DQK;
    static constexpr int CK = KW / 8, CV = DV / 8, CPR = CK + CV, TOT = 64 * CPR, NIT = (TOT + NTHR - 1) / NTHR;
    static constexpr int SK = KW * 2 + 16, SV = DV * 2 + 64, VOFF = 64 * SK, BUFB = 64 * SK + 64 * SV;
    static constexpr int NKS = DQK / 32, NVB = DV / 16;
    static constexpr bool ULD = (CA == CK);
    struct Stage { unsigned goff[NIT], gld[ULD ? 1 : NIT]; int soff[NIT]; };

    static __device__ __forceinline__ void setup(const KVSrc& s, Stage& sg) {
        int tidv = (int)threadIdx.x; asm volatile("" : "+v"(tidv));
#pragma unroll
        for (int it = 0; it < NIT; ++it) { int idx = it * NTHR + tidv; idx = idx < TOT ? idx : TOT - 1;
            const int key = idx / CPR, c = idx - key * CPR;
            const bool isk = c < CK;
            const unsigned fa = c < CA ? 1u : 0u, fv = isk ? 0u : 1u, fb = 1u - fa - fv;
            const unsigned base = fa * s.ka + fb * s.kb + fv * s.v; const unsigned ld = fa * (unsigned)s.lda + fb * (unsigned)s.ldb + fv * (unsigned)s.ldv;
            const unsigned col = fa * (unsigned)(s.offa + c * 8) + fb * (unsigned)(s.offb + (c - CA) * 8) + fv * (unsigned)(s.offv + (c - CK) * 8);
            sg.goff[it] = base + ((unsigned)key * ld + col) * 2u; if (!ULD || it == 0) sg.gld[ULD ? 0 : it] = ULD ? (unsigned)s.lda * 2u : ld * 2u;
            sg.soff[it] = isk ? key * SK + c * 16 : VOFF + key * SV + (c - CK) * 16; }
    }
    static __device__ __forceinline__ void gload(const unsigned char* wsb, const KVSrc& s, const Stage& sg, int t, u32x4 (&st)[NIT]) {
        const unsigned rowbase = (unsigned)(t < CTX / 64 ? s.ctx_row0 + t * 64 : s.lat_row0 + (t - CTX / 64) * 64);
#pragma unroll
        for (int it = 0; it < NIT; ++it) st[it] = *(const u32x4*)(wsb + (sg.goff[it] + rowbase * sg.gld[ULD ? 0 : it]));
    }
    static __device__ __forceinline__ void sstore(LAS unsigned char* buf, const Stage& sg, const u32x4 (&st)[NIT]) {
#pragma unroll
        for (int it = 0; it < NIT; ++it) { if ((it + 1) * NTHR <= TOT || it * NTHR + (int)threadIdx.x < TOT) *(LAS u32x4*)(buf + sg.soff[it]) = st[it]; }
    }
    static __device__ __forceinline__ float vmax2(float a, float b) { float r; asm("v_max_f32 %0, %1, %2" : "=v"(r) : "v"(a), "v"(b)); return r; }
    static __device__ __forceinline__ float vmax3(float a, float b, float c) { float r; asm("v_max3_f32 %0, %1, %2, %3" : "=v"(r) : "v"(a), "v"(b), "v"(c)); return r; }
    static __device__ __forceinline__ void softmax_slot(f32x4 (&sq)[4], f32x4 (&o)[NVB][2], int qb, float& m, float& l, bf16x8 (&pf)[2]) {
        float mx = vmax3(sq[0][0], sq[0][1], sq[0][2]); mx = vmax3(mx, sq[0][3], sq[1][0]); mx = vmax3(mx, sq[1][1], sq[1][2]); mx = vmax3(mx, sq[1][3], sq[2][0]);
        mx = vmax3(mx, sq[2][1], sq[2][2]); mx = vmax3(mx, sq[2][3], sq[3][0]); mx = vmax3(mx, sq[3][1], sq[3][2]); mx = vmax2(mx, sq[3][3]);
        { const auto r = __builtin_amdgcn_permlane16_swap(__float_as_uint(mx), __float_as_uint(mx), false, false); mx = vmax2(__uint_as_float(r[0]), __uint_as_float(r[1])); }
        { const auto r = __builtin_amdgcn_permlane32_swap(__float_as_uint(mx), __float_as_uint(mx), false, false); mx = vmax2(__uint_as_float(r[0]), __uint_as_float(r[1])); }
        if (__builtin_amdgcn_ballot_w64(mx > 8.0f) != 0ull) {
            const float delta = vmax2(mx, 0.0f); const float alpha = __builtin_amdgcn_exp2f(-delta); m += delta; l = l * alpha;
#pragma unroll
            for (int vb = 0; vb < NVB; ++vb) o[vb][qb] = o[vb][qb] * alpha;
#pragma unroll
            for (int kb = 0; kb < 4; ++kb) sq[kb] = sq[kb] - delta;
        }
        float ps = 0.f;
#pragma unroll
        for (int kb = 0; kb < 4; ++kb) {
#pragma unroll
            for (int j = 0; j < 4; ++j) { const float pv = __builtin_amdgcn_exp2f(sq[kb][j]); sq[kb][j] = pv; ps += pv; } }
        l += ps;
#pragma unroll
        for (int k2 = 0; k2 < 2; ++k2) { u32x4 w; w.x = cvt_pk_bf16(sq[2 * k2][0], sq[2 * k2][1]); w.y = cvt_pk_bf16(sq[2 * k2][2], sq[2 * k2][3]);
            w.z = cvt_pk_bf16(sq[2 * k2 + 1][0], sq[2 * k2 + 1][1]); w.w = cvt_pk_bf16(sq[2 * k2 + 1][2], sq[2 * k2 + 1][3]);
            pf[k2] = __builtin_bit_cast(bf16x8, w); }
    }
    static __device__ __forceinline__ bf16x8 vread(LAS unsigned char* a) {
        const s16x4 v0 = __builtin_amdgcn_ds_read_tr16_b64_v4i16((LAS s16x4*)a);
        const s16x4 v1 = __builtin_amdgcn_ds_read_tr16_b64_v4i16((LAS s16x4*)(a + 16 * SV));
        return __builtin_shufflevector(v0, v1, 0, 1, 2, 3, 4, 5, 6, 7);
    }
    static __device__ __forceinline__ void tile(LAS unsigned char* buf, const bf16x8 (&qf)[2][NKS], f32x4 (&o)[NVB][2], float (&m)[2], float (&l)[2], int koff, int voff) {
        bf16x8 pf[2][2];
        f32x4 sa[2][4];
#pragma unroll
        for (int kb = 0; kb < 4; ++kb) { sa[0][kb] = (f32x4){-m[0], -m[0], -m[0], -m[0]}; sa[1][kb] = (f32x4){-m[1], -m[1], -m[1], -m[1]}; }
        if constexpr (PAIR) {
#pragma unroll
            for (int hb = 0; hb < 2; ++hb) {
                bf16x8 kf[2][2][NKS];
#pragma unroll
                for (int k = 0; k < 2; ++k)
#pragma unroll
                    for (int qb = 0; qb < 2; ++qb)
#pragma unroll
                        for (int ks = 0; ks < NKS; ++ks) kf[k][qb][ks] = *(const LAS bf16x8*)(buf + koff + (hb * 2 + k) * 16 * SK + qb * DQK * 2 + ks * 64);
                __builtin_amdgcn_sched_barrier(0);
#pragma unroll
                for (int k = 0; k < 2; ++k)
#pragma unroll
                    for (int ks = 0; ks < NKS; ++ks)
#pragma unroll
                        for (int qb = 0; qb < 2; ++qb) sa[qb][hb * 2 + k] = __builtin_amdgcn_mfma_f32_16x16x32_bf16(kf[k][qb][ks], qf[qb][ks], sa[qb][hb * 2 + k], 0, 0, 0);
                __builtin_amdgcn_sched_barrier(0);
            }
        } else {
            bf16x8 kf[4][NKS];
#pragma unroll
            for (int kb = 0; kb < 4; ++kb)
#pragma unroll
                for (int ks = 0; ks < NKS; ++ks) kf[kb][ks] = *(const LAS bf16x8*)(buf + koff + kb * 16 * SK + ks * 64);
            __builtin_amdgcn_sched_barrier(0);
#pragma unroll
            for (int kb = 0; kb < 4; ++kb)
#pragma unroll
                for (int ks = 0; ks < NKS; ++ks) {
                    sa[0][kb] = __builtin_amdgcn_mfma_f32_16x16x32_bf16(kf[kb][ks], qf[0][ks], sa[0][kb], 0, 0, 0);
                    sa[1][kb] = __builtin_amdgcn_mfma_f32_16x16x32_bf16(kf[kb][ks], qf[1][ks], sa[1][kb], 0, 0, 0); }
            __builtin_amdgcn_sched_barrier(0);
        }
        constexpr int VH = NVB > 4 ? 4 : NVB;
        bf16x8 vf[VH];
#pragma unroll
        for (int vb = 0; vb < VH; ++vb) vf[vb] = vread(buf + voff + vb * 32);
        __builtin_amdgcn_sched_barrier(0);
        softmax_slot(sa[0], o, 0, m[0], l[0], pf[0]);
        softmax_slot(sa[1], o, 1, m[1], l[1], pf[1]);
        __builtin_amdgcn_sched_barrier(0);
#pragma unroll
        for (int k2 = 0; k2 < 2; ++k2)
#pragma unroll
            for (int v0 = 0; v0 < NVB; v0 += VH) {
                if (k2 != 0 || v0 != 0) {
#pragma unroll
                    for (int vb = 0; vb < VH; ++vb) vf[vb] = vread(buf + voff + k2 * 32 * SV + (v0 + vb) * 32);
                    __builtin_amdgcn_sched_barrier(0);
                }
#pragma unroll
                for (int vb = 0; vb < VH; ++vb) {
                    o[v0 + vb][0] = __builtin_amdgcn_mfma_f32_16x16x32_bf16(vf[vb], pf[0][k2], o[v0 + vb][0], 0, 0, 0);
                    o[v0 + vb][1] = __builtin_amdgcn_mfma_f32_16x16x32_bf16(vf[vb], pf[1][k2], o[v0 + vb][1], 0, 0, 0); }
                __builtin_amdgcn_sched_barrier(0);
            }
    }
    static constexpr int KBUF = 64 * SK, VBUF = 64 * SV;
    struct StageP { unsigned goff[NIT], gld[ULD ? 1 : NIT]; int soff[NIT]; unsigned kmask; };
    static __device__ __forceinline__ void setup_p(const KVSrc& s, StageP& sg) {
        int tidv = (int)threadIdx.x; asm volatile("" : "+v"(tidv));
        sg.kmask = 0u;
#pragma unroll
        for (int it = 0; it < NIT; ++it) { int idx = it * NTHR + tidv; idx = idx < TOT ? idx : TOT - 1;
            const int key = idx / CPR, c = idx - key * CPR;
            const bool isk = c < CK;
            const unsigned fa = c < CA ? 1u : 0u, fv = isk ? 0u : 1u, fb = 1u - fa - fv;
            const unsigned base = fa * s.ka + fb * s.kb + fv * s.v; const unsigned ld = fa * (unsigned)s.lda + fb * (unsigned)s.ldb + fv * (unsigned)s.ldv;
            const unsigned col = fa * (unsigned)(s.offa + c * 8) + fb * (unsigned)(s.offb + (c - CA) * 8) + fv * (unsigned)(s.offv + (c - CK) * 8);
            sg.goff[it] = base + ((unsigned)key * ld + col) * 2u; if (!ULD || it == 0) sg.gld[ULD ? 0 : it] = ULD ? (unsigned)s.lda * 2u : ld * 2u;
            sg.soff[it] = isk ? key * SK + c * 16 : key * SV + (c - CK) * 16; sg.kmask |= (isk ? 1u : 0u) << it; }
    }
    static __device__ __forceinline__ unsigned rowbase_of(const KVSrc& s, int t) { return (unsigned)(t < CTX / 64 ? s.ctx_row0 + t * 64 : s.lat_row0 + (t - CTX / 64) * 64); }
    static __device__ __forceinline__ void gload_p(const unsigned char* wsb, const KVSrc& s, const StageP& sg, int si, int ntiles, u32x4 (&st)[NIT]) {
        const unsigned rbK = rowbase_of(s, si + 1 < ntiles ? si + 1 : ntiles - 1), rbV = rowbase_of(s, si < 0 ? 0 : si);
#pragma unroll
        for (int it = 0; it < NIT; ++it) { const unsigned rb = ((sg.kmask >> it) & 1u) ? rbK : rbV; st[it] = *(const u32x4*)(wsb + (sg.goff[it] + rb * sg.gld[ULD ? 0 : it])); }
    }
    static __device__ __forceinline__ void sstore_p(LAS unsigned char* lds, const StageP& sg, int kdst, int vdst, const u32x4 (&st)[NIT]) {
#pragma unroll
        for (int it = 0; it < NIT; ++it) { if ((it + 1) * NTHR <= TOT || it * NTHR + (int)threadIdx.x < TOT) *(LAS u32x4*)(lds + sg.soff[it] + (((sg.kmask >> it) & 1u) ? kdst : vdst)) = st[it]; }
    }
    static __device__ __forceinline__ void qk_first(LAS unsigned char* kbuf, const bf16x8 (&qf)[2][NKS], f32x4 (&sa)[2][4], int koff) {
#pragma unroll
        for (int kb = 0; kb < 4; ++kb) { sa[0][kb] = (f32x4){0.f, 0.f, 0.f, 0.f}; sa[1][kb] = (f32x4){0.f, 0.f, 0.f, 0.f}; }
#pragma unroll
        for (int kb = 0; kb < 4; ++kb)
#pragma unroll
            for (int ks = 0; ks < NKS; ++ks) { const bf16x8 kf = *(const LAS bf16x8*)(kbuf + koff + kb * 16 * SK + ks * 64);
                sa[0][kb] = __builtin_amdgcn_mfma_f32_16x16x32_bf16(kf, qf[0][ks], sa[0][kb], 0, 0, 0);
                sa[1][kb] = __builtin_amdgcn_mfma_f32_16x16x32_bf16(kf, qf[1][ks], sa[1][kb], 0, 0, 0); }
    }
    static __device__ __forceinline__ void step_p(LAS unsigned char* kbuf, LAS unsigned char* vbuf, const bf16x8 (&qf)[2][NKS], f32x4 (&o)[NVB][2], float (&m)[2], float (&l)[2],
                                                 f32x4 (&cur)[2][4], f32x4 (&nxt)[2][4], int koff, int voffw) {
        bf16x8 kf[4][NKS];
#pragma unroll
        for (int kb = 0; kb < 4; ++kb)
#pragma unroll
            for (int ks = 0; ks < NKS; ++ks) kf[kb][ks] = *(const LAS bf16x8*)(kbuf + koff + kb * 16 * SK + ks * 64);
        float mx[2];
#pragma unroll
        for (int qb = 0; qb < 2; ++qb) { f32x4 (&sq)[4] = cur[qb];
            float x = vmax3(sq[0][0], sq[0][1], sq[0][2]); x = vmax3(x, sq[0][3], sq[1][0]); x = vmax3(x, sq[1][1], sq[1][2]); x = vmax3(x, sq[1][3], sq[2][0]);
            x = vmax3(x, sq[2][1], sq[2][2]); x = vmax3(x, sq[2][3], sq[3][0]); x = vmax3(x, sq[3][1], sq[3][2]); x = vmax2(x, sq[3][3]);
            { const auto r = __builtin_amdgcn_permlane16_swap(__float_as_uint(x), __float_as_uint(x), false, false); x = vmax2(__uint_as_float(r[0]), __uint_as_float(r[1])); }
            { const auto r = __builtin_amdgcn_permlane32_swap(__float_as_uint(x), __float_as_uint(x), false, false); x = vmax2(__uint_as_float(r[0]), __uint_as_float(r[1])); }
            mx[qb] = x; }
        if (__builtin_amdgcn_ballot_w64(mx[0] > 8.0f || mx[1] > 8.0f) != 0ull) {
#pragma unroll
            for (int qb = 0; qb < 2; ++qb) { const float delta = mx[qb] > 8.0f ? mx[qb] : 0.0f; const float alpha = __builtin_amdgcn_exp2f(-delta); m[qb] += delta; l[qb] *= alpha;
#pragma unroll
                for (int vb = 0; vb < NVB; ++vb) o[vb][qb] = o[vb][qb] * alpha;
#pragma unroll
                for (int kb = 0; kb < 4; ++kb) cur[qb][kb] = cur[qb][kb] - delta; }
        }
        constexpr int VH = NVB > 4 ? 4 : NVB;
        bf16x8 vf[VH];
#pragma unroll
        for (int vb = 0; vb < VH; ++vb) vf[vb] = vread(vbuf + voffw + vb * 32);
        __builtin_amdgcn_sched_barrier(0);
        float ps0 = 0.f, ps1 = 0.f;
#pragma unroll
        for (int kb = 0; kb < 4; ++kb) {
            nxt[0][kb] = (f32x4){-m[0], -m[0], -m[0], -m[0]}; nxt[1][kb] = (f32x4){-m[1], -m[1], -m[1], -m[1]};
#pragma unroll
            for (int ks = 0; ks < NKS; ++ks) {
                nxt[0][kb] = __builtin_amdgcn_mfma_f32_16x16x32_bf16(kf[kb][ks], qf[0][ks], nxt[0][kb], 0, 0, 0);
                nxt[1][kb] = __builtin_amdgcn_mfma_f32_16x16x32_bf16(kf[kb][ks], qf[1][ks], nxt[1][kb], 0, 0, 0); }
#pragma unroll
            for (int j = 0; j < 4; ++j) { const float p0 = __builtin_amdgcn_exp2f(cur[0][kb][j]); cur[0][kb][j] = p0; ps0 += p0;
                                          const float p1 = __builtin_amdgcn_exp2f(cur[1][kb][j]); cur[1][kb][j] = p1; ps1 += p1; }
        }
        l[0] += ps0; l[1] += ps1;
        bf16x8 pf[2][2];
#pragma unroll
        for (int qb = 0; qb < 2; ++qb)
#pragma unroll
            for (int k2 = 0; k2 < 2; ++k2) { u32x4 w; w.x = cvt_pk_bf16(cur[qb][2 * k2][0], cur[qb][2 * k2][1]); w.y = cvt_pk_bf16(cur[qb][2 * k2][2], cur[qb][2 * k2][3]);
                w.z = cvt_pk_bf16(cur[qb][2 * k2 + 1][0], cur[qb][2 * k2 + 1][1]); w.w = cvt_pk_bf16(cur[qb][2 * k2 + 1][2], cur[qb][2 * k2 + 1][3]);
                pf[qb][k2] = __builtin_bit_cast(bf16x8, w); }
        __builtin_amdgcn_sched_barrier(0);
#pragma unroll
        for (int k2 = 0; k2 < 2; ++k2)
#pragma unroll
            for (int v0 = 0; v0 < NVB; v0 += VH) {
                if (k2 != 0 || v0 != 0) {
#pragma unroll
                    for (int vb = 0; vb < VH; ++vb) vf[vb] = vread(vbuf + voffw + k2 * 32 * SV + (v0 + vb) * 32);
                    __builtin_amdgcn_sched_barrier(0);
                }
#pragma unroll
                for (int vb = 0; vb < VH; ++vb) {
                    o[v0 + vb][0] = __builtin_amdgcn_mfma_f32_16x16x32_bf16(vf[vb], pf[0][k2], o[v0 + vb][0], 0, 0, 0);
                    o[v0 + vb][1] = __builtin_amdgcn_mfma_f32_16x16x32_bf16(vf[vb], pf[1][k2], o[v0 + vb][1], 0, 0, 0); }
                __builtin_amdgcn_sched_barrier(0);
            }
    }
    static __device__ __forceinline__ void run_pipe(LAS unsigned char* lds, const unsigned char* wsb, const KVSrc& s, int ntiles, const bf16x8 (&qf)[2][NKS], f32x4 (&o)[NVB][2]) {
        static_assert(!PAIR, "pipelined form is for the shared-K case");
        const int lane = threadIdx.x & 63, l15 = lane & 15, g = lane >> 4;
        float m[2] = {0.f, 0.f}, l[2] = {0.f, 0.f};
#pragma unroll
        for (int vb = 0; vb < NVB; ++vb) { o[vb][0] = (f32x4){0.f, 0.f, 0.f, 0.f}; o[vb][1] = (f32x4){0.f, 0.f, 0.f, 0.f}; }
        StageP sg; setup_p(s, sg);
        u32x4 stA[NIT], stB[NIT];
        LAS unsigned char* K0 = lds; LAS unsigned char* K1 = lds + KBUF; LAS unsigned char* V0 = lds + 2 * KBUF; LAS unsigned char* V1 = lds + 2 * KBUF + VBUF;
        gload_p(wsb, s, sg, -1, ntiles, stB); gload_p(wsb, s, sg, 0, ntiles, stA);
        sstore_p(lds, sg, 0, 2 * KBUF + VBUF, stB); sstore_p(lds, sg, KBUF, 2 * KBUF, stA);
        gload_p(wsb, s, sg, 1, ntiles, stB);
        ATT_BAR();
        const int koff = l15 * SK + g * 16;
        const int voffw = (g * 4 + (l15 >> 2)) * SV + (l15 & 3) * 8;
        f32x4 saA[2][4], saB[2][4];
        qk_first(K0, qf, saA, koff);
#pragma unroll 1
        for (int t = 0; t < ntiles; t += 2) {
            gload_p(wsb, s, sg, t + 2, ntiles, stA);
            step_p(K1, V0, qf, o, m, l, saA, saB, koff, voffw);
            sstore_p(lds, sg, 0, 2 * KBUF + VBUF, stB);
            ATT_BAR();
            gload_p(wsb, s, sg, t + 3, ntiles, stB);
            step_p(K0, V1, qf, o, m, l, saB, saA, koff, voffw);
            sstore_p(lds, sg, KBUF, 2 * KBUF, stA);
            ATT_BAR();
        }
#pragma unroll
        for (int qb = 0; qb < 2; ++qb) { float lt = l[qb]; lt += __shfl_xor(lt, 16); lt += __shfl_xor(lt, 32); const float inv = 1.0f / lt;
#pragma unroll
            for (int vb = 0; vb < NVB; ++vb) o[vb][qb] = o[vb][qb] * inv; }
    }
    static constexpr int KT = 2, TOT2 = KT * TOT, NIT2 = (TOT2 + NTHR - 1) / NTHR, SBUF = KT * BUFB;
    struct Stage2 { unsigned goff[NIT2], gld[ULD ? 1 : NIT2]; int soff[NIT2]; };
    static __device__ __forceinline__ void setup2(const KVSrc& s, Stage2& sg) {
        int tidv = (int)threadIdx.x; asm volatile("" : "+v"(tidv));
#pragma unroll
        for (int it = 0; it < NIT2; ++it) { int idx = it * NTHR + tidv; idx = idx < TOT2 ? idx : TOT2 - 1;
            const int key2 = idx / CPR, c = idx - key2 * CPR, sub = key2 >> 6, key = key2 & 63;
            const bool isk = c < CK;
            const unsigned fa = c < CA ? 1u : 0u, fv = isk ? 0u : 1u, fb = 1u - fa - fv;
            const unsigned base = fa * s.ka + fb * s.kb + fv * s.v; const unsigned ld = fa * (unsigned)s.lda + fb * (unsigned)s.ldb + fv * (unsigned)s.ldv;
            const unsigned col = fa * (unsigned)(s.offa + c * 8) + fb * (unsigned)(s.offb + (c - CA) * 8) + fv * (unsigned)(s.offv + (c - CK) * 8);
            sg.goff[it] = base + ((unsigned)key2 * ld + col) * 2u; if (!ULD || it == 0) sg.gld[ULD ? 0 : it] = ULD ? (unsigned)s.lda * 2u : ld * 2u;
            sg.soff[it] = sub * BUFB + (isk ? key * SK + c * 16 : VOFF + key * SV + (c - CK) * 16); }
    }
    static __device__ __forceinline__ void gload2(const unsigned char* wsb, const KVSrc& s, const Stage2& sg, int sp, u32x4 (&st)[NIT2]) {
        const unsigned rowbase = (unsigned)(sp < CTX / 128 ? s.ctx_row0 + sp * 128 : s.lat_row0 + (sp - CTX / 128) * 128);
#pragma unroll
        for (int it = 0; it < NIT2; ++it) st[it] = *(const u32x4*)(wsb + (sg.goff[it] + rowbase * sg.gld[ULD ? 0 : it]));
    }
    static __device__ __forceinline__ void sstore2(LAS unsigned char* buf, const Stage2& sg, const u32x4 (&st)[NIT2]) {
#pragma unroll
        for (int it = 0; it < NIT2; ++it) { if ((it + 1) * NTHR <= TOT2 || it * NTHR + (int)threadIdx.x < TOT2) *(LAS u32x4*)(buf + sg.soff[it]) = st[it]; }
    }
    typedef float f32x16 __attribute__((ext_vector_type(16)));
    static constexpr int NKS16 = DQK / 16, NVB32 = DV / 32;
    static __device__ __forceinline__ void tile32(LAS unsigned char* buf, const bf16x8 (&qf)[NKS16], f32x16 (&o)[NVB32], float& m, float& l, int koff, int voff) {
        f32x16 sa[2];
#pragma unroll
        for (int kb = 0; kb < 2; ++kb)
#pragma unroll
            for (int r = 0; r < 16; ++r) sa[kb][r] = -m;
#pragma unroll
        for (int kb = 0; kb < 2; ++kb) {
            bf16x8 kf[NKS16];
#pragma unroll
            for (int ks = 0; ks < NKS16; ++ks) kf[ks] = *(const LAS bf16x8*)(buf + koff + kb * 32 * SK + ks * 32);
            __builtin_amdgcn_sched_barrier(0);
#pragma unroll
            for (int ks = 0; ks < NKS16; ++ks) sa[kb] = __builtin_amdgcn_mfma_f32_32x32x16_bf16(kf[ks], qf[ks], sa[kb], 0, 0, 0);
            __builtin_amdgcn_sched_barrier(0);
        }
        bf16x8 vf[2][NVB32];
#pragma unroll
        for (int s2 = 0; s2 < 2; ++s2)
#pragma unroll
            for (int vb = 0; vb < NVB32; ++vb) vf[s2][vb] = vread32(buf + voff + (s2 * 16) * SV + vb * 64);
        __builtin_amdgcn_sched_barrier(0);
        float mx = vmax3(sa[0][0], sa[0][1], sa[0][2]);
#pragma unroll
        for (int r = 3; r < 15; r += 2) mx = vmax3(mx, sa[0][r], sa[0][r + 1]);
        mx = vmax2(mx, sa[0][15]);
#pragma unroll
        for (int r = 0; r < 16; r += 2) mx = vmax3(mx, sa[1][r], sa[1][r + 1]);
        { const auto rr = __builtin_amdgcn_permlane32_swap(__float_as_uint(mx), __float_as_uint(mx), false, false); mx = vmax2(__uint_as_float(rr[0]), __uint_as_float(rr[1])); }
        if (__builtin_amdgcn_ballot_w64(mx > 8.0f) != 0ull) {
            const float delta = vmax2(mx, 0.0f); const float alpha = __builtin_amdgcn_exp2f(-delta); m += delta; l = l * alpha;
#pragma unroll
            for (int vb = 0; vb < NVB32; ++vb) o[vb] = o[vb] * alpha;
#pragma unroll
            for (int kb = 0; kb < 2; ++kb) sa[kb] = sa[kb] - delta;
        }
        float ps = 0.f;
#pragma unroll
        for (int kb = 0; kb < 2; ++kb)
#pragma unroll
            for (int r = 0; r < 16; ++r) { const float pv = __builtin_amdgcn_exp2f(sa[kb][r]); sa[kb][r] = pv; ps += pv; }
        l += ps;
        bf16x8 pf[2][2];
#pragma unroll
        for (int kb = 0; kb < 2; ++kb)
#pragma unroll
            for (int s2 = 0; s2 < 2; ++s2) { u32x4 w; w.x = cvt_pk_bf16(sa[kb][8 * s2 + 0], sa[kb][8 * s2 + 1]); w.y = cvt_pk_bf16(sa[kb][8 * s2 + 2], sa[kb][8 * s2 + 3]);
                w.z = cvt_pk_bf16(sa[kb][8 * s2 + 4], sa[kb][8 * s2 + 5]); w.w = cvt_pk_bf16(sa[kb][8 * s2 + 6], sa[kb][8 * s2 + 7]);
                pf[kb][s2] = __builtin_bit_cast(bf16x8, w); }
        __builtin_amdgcn_sched_barrier(0);
#pragma unroll
        for (int kb = 0; kb < 2; ++kb) {
            if (kb == 1) {
#pragma unroll
                for (int s2 = 0; s2 < 2; ++s2)
#pragma unroll
                    for (int vb = 0; vb < NVB32; ++vb) vf[s2][vb] = vread32(buf + voff + (32 + s2 * 16) * SV + vb * 64);
                __builtin_amdgcn_sched_barrier(0);
            }
#pragma unroll
            for (int s2 = 0; s2 < 2; ++s2)
#pragma unroll
                for (int vb = 0; vb < NVB32; ++vb) o[vb] = __builtin_amdgcn_mfma_f32_32x32x16_bf16(vf[s2][vb], pf[kb][s2], o[vb], 0, 0, 0);
            __builtin_amdgcn_sched_barrier(0);
        }
    }
    static __device__ __forceinline__ bf16x8 vread32(LAS unsigned char* a) {
        const s16x4 v0 = __builtin_amdgcn_ds_read_tr16_b64_v4i16((LAS s16x4*)a);
        const s16x4 v1 = __builtin_amdgcn_ds_read_tr16_b64_v4i16((LAS s16x4*)(a + 8 * SV));
        return __builtin_shufflevector(v0, v1, 0, 1, 2, 3, 4, 5, 6, 7);
    }
    static __device__ __forceinline__ void run2_32(LAS unsigned char* lds, const unsigned char* wsb, const KVSrc& s, int ntiles, const bf16x8 (&qf)[NKS16], f32x16 (&o)[NVB32], int kcol = 0) {
        const int lane = threadIdx.x & 63, l31 = lane & 31, hi = lane >> 5, li = lane & 15, nsup = ntiles >> 1;
        float m = 0.f, l = 0.f;
#pragma unroll
        for (int vb = 0; vb < NVB32; ++vb)
#pragma unroll
            for (int r = 0; r < 16; ++r) o[vb][r] = 0.f;
        Stage2 sg; setup2(s, sg);
        u32x4 st[NIT2];
        gload2(wsb, s, sg, 0, st); sstore2(lds, sg, st); ATT_BAR();
        const int koff = l31 * SK + hi * 16 + kcol;
        const int voff = VOFF + (4 * hi + (li >> 2)) * SV + (((lane >> 4) & 1) * 16 + (li & 3) * 4) * 2;
#pragma unroll 1
        for (int sp = 0; sp < nsup; sp += 2) {
            gload2(wsb, s, sg, sp + 1, st);
            tile32(lds, qf, o, m, l, koff, voff);
            tile32(lds + BUFB, qf, o, m, l, koff, voff);
            sstore2(lds + SBUF, sg, st);
            ATT_BAR();
            gload2(wsb, s, sg, sp + 2 < nsup ? sp + 2 : nsup - 1, st);
            tile32(lds + SBUF, qf, o, m, l, koff, voff);
            tile32(lds + SBUF + BUFB, qf, o, m, l, koff, voff);
            sstore2(lds, sg, st);
            ATT_BAR();
        }
        { const auto rr = __builtin_amdgcn_permlane32_swap(__float_as_uint(l), __float_as_uint(l), false, false); l = __uint_as_float(rr[0]) + __uint_as_float(rr[1]); }
        const float inv = 1.0f / l;
#pragma unroll
        for (int vb = 0; vb < NVB32; ++vb) o[vb] = o[vb] * inv;
    }
    static __device__ __forceinline__ void run2(LAS unsigned char* lds, const unsigned char* wsb, const KVSrc& s, int ntiles, const bf16x8 (&qf)[2][NKS], f32x4 (&o)[NVB][2]) {
        const int lane = threadIdx.x & 63, l15 = lane & 15, g = lane >> 4, nsup = ntiles >> 1;
        float m[2] = {0.f, 0.f}, l[2] = {0.f, 0.f};
#pragma unroll
        for (int vb = 0; vb < NVB; ++vb) { o[vb][0] = (f32x4){0.f, 0.f, 0.f, 0.f}; o[vb][1] = (f32x4){0.f, 0.f, 0.f, 0.f}; }
        Stage2 sg; setup2(s, sg);
        u32x4 st[NIT2];
        gload2(wsb, s, sg, 0, st); sstore2(lds, sg, st); ATT_BAR();
        const int koff = l15 * SK + g * 16;
        const int voff = VOFF + (g * 4 + (l15 >> 2)) * SV + (l15 & 3) * 8;
#pragma unroll 1
        for (int sp = 0; sp < nsup; sp += 2) {
            gload2(wsb, s, sg, sp + 1, st);
            tile(lds, qf, o, m, l, koff, voff);
            tile(lds + BUFB, qf, o, m, l, koff, voff);
            sstore2(lds + SBUF, sg, st);
            ATT_BAR();
            gload2(wsb, s, sg, sp + 2 < nsup ? sp + 2 : nsup - 1, st);
            tile(lds + SBUF, qf, o, m, l, koff, voff);
            tile(lds + SBUF + BUFB, qf, o, m, l, koff, voff);
            sstore2(lds, sg, st);
            ATT_BAR();
        }
#pragma unroll
        for (int qb = 0; qb < 2; ++qb) { float lt = l[qb]; lt += __shfl_xor(lt, 16); lt += __shfl_xor(lt, 32); const float inv = 1.0f / lt;
#pragma unroll
            for (int vb = 0; vb < NVB; ++vb) o[vb][qb] = o[vb][qb] * inv; }
    }
    static __device__ __forceinline__ void run(LAS unsigned char* lds, const unsigned char* wsb, const KVSrc& s, int ntiles, const bf16x8 (&qf)[2][NKS], f32x4 (&o)[NVB][2]) {
        const int lane = threadIdx.x & 63, l15 = lane & 15, g = lane >> 4;
        float m[2] = {0.f, 0.f}, l[2] = {0.f, 0.f};
#pragma unroll
        for (int vb = 0; vb < NVB; ++vb) { o[vb][0] = (f32x4){0.f, 0.f, 0.f, 0.f}; o[vb][1] = (f32x4){0.f, 0.f, 0.f, 0.f}; }
        Stage sg; setup(s, sg);
        u32x4 stA[NIT], stB[NIT];
        gload(wsb, s, sg, 0, stA); gload(wsb, s, sg, 1, stB); sstore(lds, sg, stA); ATT_BAR();
        const int koff = l15 * SK + g * 16;
        const int voff = VOFF + (g * 4 + (l15 >> 2)) * SV + (l15 & 3) * 8;
#pragma unroll 1
        for (int t = 0; t < ntiles; t += 2) {
            gload(wsb, s, sg, t + 2 < ntiles ? t + 2 : ntiles - 1, stA);
            tile(lds, qf, o, m, l, koff, voff);
#if PROBE_DUP == 300
            if (!PAIR) tile(lds, qf, o, m, l, koff, voff);
#endif
            sstore(lds + BUFB, sg, stB);
            ATT_BAR();
            gload(wsb, s, sg, t + 3 < ntiles ? t + 3 : ntiles - 1, stB);
            tile(lds + BUFB, qf, o, m, l, koff, voff);
#if PROBE_DUP == 300
            if (!PAIR) tile(lds + BUFB, qf, o, m, l, koff, voff);
#endif
            sstore(lds, sg, stA);
            ATT_BAR();
        }
#pragma unroll
        for (int qb = 0; qb < 2; ++qb) { float lt = l[qb]; lt += __shfl_xor(lt, 16); lt += __shfl_xor(lt, 32); const float inv = 1.0f / lt;
#pragma unroll
            for (int vb = 0; vb < NVB; ++vb) o[vb][qb] = o[vb][qb] * inv; }
    }
};

__device__ __forceinline__ void diffattn_phase(const Params& p, LAS unsigned char* lds, int nrep) {
    typedef AttnCore<64, 128, 16, true> AC;
    const int tid = threadIdx.x, lane = tid & 63, wid = tid >> 6, rg = wid & 3, jw = wid >> 2, l31 = lane & 31, hi = lane >> 5, G = gridDim.x;
    const int vcu = (G % 8 == 0) ? ((int)blockIdx.x % 8) * (G / 8) + (int)blockIdx.x / 8 : (int)blockIdx.x;
    const bf16_t* P = (const bf16_t*)(p.ws + WS_P); bf16_t* MIX = (bf16_t*)(p.ws + WS_MIX);
    float lam;
    { const float a = wave_sum(p.in[17][lane] * p.in[18][lane]), b = wave_sum(p.in[19][lane] * p.in[20][lane]); lam = __expf(a) - __expf(b) + LAM_INIT0; }
    const float* qg = p.in[15]; const float* sg = p.in[21];
    const float qscale = 0.125f * LOG2E;
#pragma unroll 1
    for (int uu = vcu; uu < 576 * nrep; uu += G) {
        const int u = uu % 576;
        int b, h, qrow0, ntiles, pos0; const bool lat = u < 512;
        if (lat) { const int qblk = u & 15; h = (u >> 4) & 3; b = u >> 6; pos0 = qblk * 128 + rg * 32; qrow0 = b * SEQ + pos0; ntiles = NKEY / 64; }
        else { const int uc = u - 512; const int qblk = uc & 1; h = (uc >> 1) & 3; b = uc >> 3; pos0 = qblk * 128 + rg * 32; qrow0 = MLAT + b * CTX + pos0; ntiles = CTX / 64; }
        bf16x8 qf[4];
        {
            int hq = hi, zq = 0; asm volatile("" : "+v"(hq), "+v"(zq));
            const bf16_t* qp = P + (size_t)(qrow0 + l31) * 2048 + 512 + (h * 2 + jw) * 64 + hq * 8;
            float x[4][8]; float ss = 0.f;
#pragma unroll
            for (int ks = 0; ks < 4; ++ks) { unpack8(*(const u32x4*)(qp + ks * 16), x[ks]);
#pragma unroll
                for (int e = 0; e < 8; ++e) ss += x[ks][e] * x[ks][e]; }
            ss = sum_x32(ss);
            const float rstd = rsqrtf(ss * (1.0f / 64.0f) + EPS) * qscale;
#pragma unroll
            for (int ks = 0; ks < 4; ++ks)
#pragma unroll
                for (int e = 0; e < 8; ++e) x[ks][e] = x[ks][e] * rstd * qg[ks * 16 + hq * 8 + e];
            if (lat) { const int pos = pos0 + l31; const float prow = (float)(pos >> 6), pcol = (float)(pos & 63);
#pragma unroll
                for (int e = 0; e < 8; ++e) { const float fq = rope_freq(hq * 8 + e + zq, 1.0f / 16.0f); float sn, cs;
                    fast_sincos(prow * fq, sn, cs); { const float a = x[0][e], c = x[2][e]; x[0][e] = a * cs - c * sn; x[2][e] = a * sn + c * cs; }
                    fast_sincos(pcol * fq, sn, cs); { const float a = x[1][e], c = x[3][e]; x[1][e] = a * cs - c * sn; x[3][e] = a * sn + c * cs; } } }
#pragma unroll
            for (int ks = 0; ks < 4; ++ks) qf[ks] = __builtin_bit_cast(bf16x8, pack8(x[ks]));
        }
        KVSrc s; s.ka = (unsigned)WS_P; s.lda = 2048; s.offa = 1024 + h * 128; s.kb = (unsigned)WS_P; s.ldb = 2048; s.offb = 0; s.v = (unsigned)WS_P; s.ldv = 2048; s.offv = 1536 + h * 128;
        s.ctx_row0 = MLAT + b * CTX; s.lat_row0 = b * SEQ;
        AC::f32x16 o[4];
        AC::run2_32(lds, p.ws, s, ntiles, qf, o, jw * 128);
        LAS float* xch = (LAS float*)lds + rg * 4096 + lane;
        if (jw == 1) {
#pragma unroll
            for (int vb = 0; vb < 4; ++vb)
#pragma unroll
                for (int r = 0; r < 16; ++r) xch[(vb * 16 + r) * 64] = o[vb][r];
        }
        ATT_BAR();
        if (jw == 0) {
            float ss = 0.f;
#pragma unroll
            for (int vb = 0; vb < 4; ++vb)
#pragma unroll
                for (int r = 0; r < 16; ++r) { const float d = o[vb][r] - xch[(vb * 16 + r) * 64] * lam; o[vb][r] = d; ss += d * d; }
            ss = sum_x32(ss);
            const float rstd = rsqrtf(ss * (1.0f / 128.0f) + EPS) * (1.0f - LAM_INIT0);
            bf16_t* op = MIX + (size_t)(qrow0 + l31) * 1024 + 512 + h * 128 + 4 * hi;
#pragma unroll
            for (int vb = 0; vb < 4; ++vb)
#pragma unroll
                for (int r4 = 0; r4 < 4; ++r4) { const f32x4 gg = *(const f32x4*)(sg + vb * 32 + r4 * 8 + 4 * hi);
                    u32x2 w; w.x = cvt_pk_bf16(o[vb][4 * r4 + 0] * rstd * gg[0], o[vb][4 * r4 + 1] * rstd * gg[1]); w.y = cvt_pk_bf16(o[vb][4 * r4 + 2] * rstd * gg[2], o[vb][4 * r4 + 3] * rstd * gg[3]);
                    *(u32x2*)(op + vb * 32 + r4 * 8) = w; }
        }
        ATT_BAR();
    }
}

__device__ __forceinline__ void latnorm_phase(const Params& p, bool dry) {
    constexpr int RB = 3;
    const int lane = threadIdx.x & 63, wid = threadIdx.x >> 6, nw = gridDim.x * 8;
    bf16_t* C = (bf16_t*)(p.ws + WS_CQKV); const float* gq = p.in[23]; const float* gkv = p.in[26];
    const int lq = lane < 48 ? lane : 0, lk = lane < 32 ? lane : 0;
    float gqv[8], gkvv[8];
#pragma unroll
    for (int e = 0; e < 8; ++e) { gqv[e] = gq[lq * 8 + e]; gkvv[e] = gkv[lk * 8 + e]; }
    for (int r0 = blockIdx.x * 8 + wid; r0 < MTOT; r0 += nw * RB) {
        u32x4 wq[RB], wk[RB];
#pragma unroll
        for (int u = 0; u < RB; ++u) { int r = r0 + u * nw; r = r < MTOT ? r : r0; const bf16_t* rp = C + (size_t)r * 768;
            wq[u] = *(const u32x4*)(rp + lq * 8); wk[u] = *(const u32x4*)(rp + 384 + lk * 8); }
#pragma unroll
        for (int u = 0; u < RB; ++u) { const int r = r0 + u * nw; if (r >= MTOT) break;
            bf16_t* rp = C + (size_t)r * 768; bf16_t* wp = dry ? (bf16_t*)(p.ws + WS_KVRAW) + (size_t)r * 768 : rp;
            float xq[8], xk[8]; unpack8(wq[u], xq); unpack8(wk[u], xk);
            float sq = 0.f, sk = 0.f;
#pragma unroll
            for (int e = 0; e < 8; ++e) { sq += xq[e] * xq[e]; sk += xk[e] * xk[e]; }
            sq = wave_sum(lane < 48 ? sq : 0.f); sk = wave_sum(lane < 32 ? sk : 0.f);
            const float rq = rsqrtf(sq * (1.0f / 384.0f) + EPS), rk = rsqrtf(sk * (1.0f / 256.0f) + EPS);
#pragma unroll
            for (int e = 0; e < 8; ++e) { xq[e] = xq[e] * rq * gqv[e]; xk[e] = xk[e] * rk * gkvv[e]; }
            if (lane < 48) *(u32x4*)(wp + lane * 8) = pack8(xq);
            if (lane < 32) *(u32x4*)(wp + 384 + lane * 8) = pack8(xk); }
    }
}
__device__ __forceinline__ void kprepL1_phase(const Params& p, bool dry) {
    constexpr int RB = 3;
    const int lane = threadIdx.x & 63, wid = threadIdx.x >> 6, h = lane >> 2, part = lane & 3, nw = gridDim.x * 8;
    bf16_t* KV = (bf16_t*)(p.ws + WS_KVRAW); const bf16_t* C = (const bf16_t*)(p.ws + WS_CQKV); bf16_t* KR = (bf16_t*)(p.ws + WS_KRN);
    const float* kg = p.in[29];
    float g0[8], g1[8], gr1[8], gr2[8], fr8[8];
#pragma unroll
    for (int e = 0; e < 8; ++e) { g0[e] = kg[part * 16 + e]; g1[e] = kg[part * 16 + 8 + e]; gr1[e] = kg[64 + (part & 1) * 8 + e]; gr2[e] = kg[80 + (part & 1) * 8 + e]; fr8[e] = rope_freq(e, 1.0f / 8.0f); }
    for (int r0 = blockIdx.x * 8 + wid; r0 < MTOT; r0 += nw * RB) {
        u32x4 wa[RB], wb[RB], w1[RB], w2[RB];
#pragma unroll
        for (int u = 0; u < RB; ++u) { int r = r0 + u * nw; r = r < MTOT ? r : r0;
            const bf16_t* kp = KV + (size_t)r * 2048 + h * 128 + part * 16; const bf16_t* rp = C + (size_t)r * 768 + 640 + (part & 1) * 8;
            wa[u] = *(const u32x4*)kp; wb[u] = *(const u32x4*)(kp + 8); w1[u] = *(const u32x4*)rp; w2[u] = *(const u32x4*)(rp + 16); }
#pragma unroll
        for (int u = 0; u < RB; ++u) { const int r = r0 + u * nw; if (r >= MTOT) break;
            bf16_t* kp = KV + (size_t)r * 2048 + h * 128 + part * 16;
            float a[8], b[8], x1[8], x2[8];
            unpack8(wa[u], a); unpack8(wb[u], b); unpack8(w1[u], x1); unpack8(w2[u], x2);
            float ss = 0.f, sr = 0.f;
#pragma unroll
            for (int e = 0; e < 8; ++e) { ss += a[e] * a[e] + b[e] * b[e]; sr += x1[e] * x1[e] + x2[e] * x2[e]; }
            ss = sum_x2(sum_x1(ss)); sr = sum_x1(sr);
            const float rstd = rsqrtf((ss + sr) * (1.0f / 96.0f) + EPS);
#pragma unroll
            for (int e = 0; e < 8; ++e) { a[e] = a[e] * rstd * g0[e]; b[e] = b[e] * rstd * g1[e]; }
            { bf16_t* kd = dry ? (bf16_t*)(p.ws + WS_A) + (size_t)r * 1024 + h * 64 + part * 16 : kp; *(u32x4*)kd = pack8(a); *(u32x4*)(kd + 8) = pack8(b); }
            const bool lat = r < MLAT; const int t = r & 2047; const float pos = (part & 1) ? (float)(t & 63) : (float)(t >> 6);
            float outv[8];
#pragma unroll
            for (int e = 0; e < 8; ++e) { const float y1 = x1[e] * rstd * gr1[e], y2 = x2[e] * rstd * gr2[e]; float sn = 0.f, cs = 1.f;
                if (lat) fast_sincos(pos * fr8[e], sn, cs);
                outv[e] = (part & 2) ? (y1 * sn + y2 * cs) : (y1 * cs - y2 * sn); }
            *(u32x4*)(KR + (size_t)r * 512 + h * 32 + part * 8) = pack8(outv); }
    }
}

__device__ __forceinline__ void mla_phase(const Params& p, LAS unsigned char* lds, int nrep) {
    typedef AttnCore<96, 64, 8, false> AC;
    const int tid = threadIdx.x, lane = tid & 63, wid = tid >> 6, l15 = lane & 15, g = lane >> 4, G = gridDim.x;
    const int vcu = (G % 8 == 0) ? ((int)blockIdx.x % 8) * (G / 8) + (int)blockIdx.x / 8 : (int)blockIdx.x;
    const bf16_t* Q = (const bf16_t*)(p.ws + WS_QRAW); const bf16_t* KV = (const bf16_t*)(p.ws + WS_KVRAW); const bf16_t* KR = (const bf16_t*)(p.ws + WS_KRN);
    bf16_t* O = (bf16_t*)(p.ws + WS_A);
    const float* qg = p.in[28];
    const float qscale = 0.10206207261596577f * LOG2E;
#pragma unroll 1
    for (int uu = vcu; uu < 1024 * nrep; uu += G) {
        const int u = uu & 1023;
        const int qblk = u & 7, h = (u >> 3) & 15, b = u >> 7;
        const int pos0 = qblk * 256 + wid * 32, qrow0 = b * SEQ + pos0;
        const int l31 = lane & 31, hi = lane >> 5;
        bf16x8 qf[6];
        {
            int hq = hi, zq = 0; asm volatile("" : "+v"(hq), "+v"(zq));
            const bf16_t* qp = Q + (size_t)(qrow0 + l31) * 1536 + h * 96 + hq * 8;
            float x[6][8]; float ss = 0.f;
#pragma unroll
            for (int ks = 0; ks < 6; ++ks) { unpack8(*(const u32x4*)(qp + ks * 16), x[ks]);
#pragma unroll
                for (int e = 0; e < 8; ++e) ss += x[ks][e] * x[ks][e]; }
            ss = sum_x32(ss);
            const float epsq = EPS * (((const float*)(p.ws + WS_SS))[qrow0 + l31] * (1.0f / 384.0f) + EPS);
            const float rstd = rsqrtf(ss * (1.0f / 96.0f) + epsq);
            const int pos = pos0 + l31; const float pf_ = hq ? (float)(pos & 63) : (float)(pos >> 6);
#pragma unroll
            for (int ks = 0; ks < 6; ++ks)
#pragma unroll
                for (int e = 0; e < 8; ++e) x[ks][e] = x[ks][e] * rstd * qg[ks * 16 + hq * 8 + e];
#pragma unroll
            for (int e = 0; e < 8; ++e) { float sn, cs; fast_sincos(pf_ * rope_freq(e + zq, 1.0f / 8.0f), sn, cs);
                const float a = x[4][e], c = x[5][e]; x[4][e] = a * cs - c * sn; x[5][e] = a * sn + c * cs; }
#pragma unroll
            for (int ks = 0; ks < 6; ++ks) {
#pragma unroll
                for (int e = 0; e < 8; ++e) x[ks][e] *= qscale;
                qf[ks] = __builtin_bit_cast(bf16x8, pack8(x[ks])); }
        }
        KVSrc s; s.ka = (unsigned)WS_KVRAW; s.lda = 2048; s.offa = h * 128; s.kb = (unsigned)WS_KRN; s.ldb = 512; s.offb = h * 32; s.v = (unsigned)WS_KVRAW; s.ldv = 2048; s.offv = h * 128 + 64;
        s.ctx_row0 = MLAT + b * CTX; s.lat_row0 = b * SEQ;
        AC::f32x16 o[2];
        AC::run2_32(lds, p.ws, s, NKEY / 64, qf, o);
        { bf16_t* op = O + (size_t)(qrow0 + l31) * 1024 + h * 64 + 4 * hi;
#pragma unroll
          for (int vb = 0; vb < 2; ++vb)
#pragma unroll
              for (int r4 = 0; r4 < 4; ++r4) { u32x2 w; w.x = cvt_pk_bf16(o[vb][4 * r4 + 0], o[vb][4 * r4 + 1]); w.y = cvt_pk_bf16(o[vb][4 * r4 + 2], o[vb][4 * r4 + 3]);
                  *(u32x2*)(op + vb * 32 + r4 * 8) = w; } }
    }
}
#define XB_TMO      128
#define XB_XCNT(j)  (256  + 64 * (j))
#define XB_XSUB(j)  (1280 + 64 * (j))
#define XB_XGEN(j)  (2304 + 64 * (j))
#define XB_TOP      3328
#define XB_TOPGEN   3392
#define XCD_BAR_WORDS 3456
#define XB_SPIN_CAP (1u << 18)

__device__ __forceinline__ unsigned xb_ld(unsigned* p)              { return __hip_atomic_load(p, __ATOMIC_RELAXED, __HIP_MEMORY_SCOPE_AGENT); }
__device__ __forceinline__ unsigned xb_add(unsigned* p, unsigned v) { return __hip_atomic_fetch_add(p, v, __ATOMIC_RELAXED, __HIP_MEMORY_SCOPE_AGENT); }
__device__ __forceinline__ unsigned xb_xcc_id() { return (unsigned)__builtin_amdgcn_s_getreg((3 << 11) | 20) & 0xFu; }
#define XB_SPIN(cond, bar) do { unsigned _sp = 0; while (cond) { __builtin_amdgcn_s_sleep(1); \
    if ((++_sp & 255u) == 0u) { if (xb_ld(&(bar)[XB_TMO])) break; if (_sp > XB_SPIN_CAP) { atomicAdd(&(bar)[XB_TMO], 1u); break; } } } } while (0)

struct XcdBarrier {
    unsigned* bar; unsigned x;
    volatile LAS unsigned* st;
};

__device__ __forceinline__ XcdBarrier xcd_barrier_post(unsigned* bar, volatile LAS unsigned* st) {
    XcdBarrier b; b.bar = bar; b.x = xb_xcc_id(); b.st = st;
    if (threadIdx.x == 0) (void)xb_add(&bar[XB_XCNT(b.x)], 1u);
    return b;
}
__device__ __forceinline__ void xcd_barrier_complete(unsigned* bar, unsigned x, unsigned& nloc, unsigned& nx) {
    const unsigned G = gridDim.x * gridDim.y * gridDim.z;
    unsigned sum, cnt, mine, sp = 0u;
    for (;;) {
        sum = 0u; cnt = 0u; mine = 0u;
#pragma unroll
        for (unsigned j = 0; j < 16; ++j) { const unsigned c = xb_ld(&bar[XB_XCNT(j)]); sum += c; cnt += (c > 0u) ? 1u : 0u; mine = (j == x) ? c : mine; }
        if (sum == G) break;
        __builtin_amdgcn_s_sleep(1);
        if ((++sp & 255u) == 0u) { if (xb_ld(&bar[XB_TMO])) break; if (sp > XB_SPIN_CAP) { atomicAdd(&bar[XB_TMO], 1u); break; } }
    }
    nloc = mine > 0u ? mine : 1u; nx = cnt > 0u ? cnt : 1u;
}

__device__ __forceinline__ void xcd_barrier(const XcdBarrier& b) {
    asm volatile("s_waitcnt vmcnt(0)" ::: "memory");
    __syncthreads();
    if (threadIdx.x == 0) {
        unsigned* bar = b.bar;
        __builtin_amdgcn_s_waitcnt(0);
        unsigned nloc = b.st[0], nx = b.st[1];
        if (nloc == 0u) { xcd_barrier_complete(bar, b.x, nloc, nx); b.st[0] = nloc; b.st[1] = nx; }
        const unsigned old = xb_add(&bar[XB_XSUB(b.x)], 1u);
        const unsigned gen = old / nloc;
        if (old + 1u == (gen + 1u) * nloc) {
            __builtin_amdgcn_fence(__ATOMIC_RELEASE, "agent");
            asm volatile("s_waitcnt vmcnt(0)" ::: "memory");
            const unsigned og = xb_add(&bar[XB_TOP], 1u);
            const unsigned tg = og / nx;
            if (og + 1u == (tg + 1u) * nx) xb_add(&bar[XB_TOPGEN], 1u);
            else XB_SPIN(xb_ld(&bar[XB_TOPGEN]) == tg, bar);
            __builtin_amdgcn_fence(__ATOMIC_ACQUIRE, "agent");
            xb_add(&bar[XB_XGEN(b.x)], 1u);
            asm volatile("s_waitcnt vmcnt(0)" ::: "memory");
        } else {
            XB_SPIN(xb_ld(&bar[XB_XGEN(b.x)]) == gen, bar);
            __builtin_amdgcn_fence(__ATOMIC_ACQUIRE, "agent");
            asm volatile("s_waitcnt vmcnt(0)" ::: "memory");
        }
    }
    __syncthreads();
}


constexpr int LDS_BYTES = 151680;
constexpr int LDS_BST = LDS_BYTES - 64;
static_assert(XCD_BAR_WORDS * 4 <= 16384, "barrier words do not fit their slot");
static_assert(WS_SS + (size_t)2 * MTOT * 4 <= (size_t)256 * 1024 * 1024, "workspace too large");
constexpr int N_PHASES = 19;

__global__ void __launch_bounds__(NTHR, 2) fwd_megakernel(Params p) {
    extern __shared__ __attribute__((aligned(16))) unsigned char lds_raw[];
    LAS unsigned char* lds = (LAS unsigned char*)lds_raw;
    cg::grid_group grid = cg::this_grid();
    volatile LAS unsigned* bst = (volatile LAS unsigned*)(lds + LDS_BST);
    if (threadIdx.x < 16) bst[threadIdx.x] = 0u;
    __syncthreads();
    XcdBarrier bar = xcd_barrier_post((unsigned*)(p.ws + WS_BAR), bst);
    unsigned char* ws = p.ws;
    const int lo = p.ph_lo, hi = p.ph_hi;
    float* MOD = (float*)(ws + WS_MOD);
    float* HL = p.out; float* HC = (float*)(ws + WS_HC);
    bf16_t* A = (bf16_t*)(ws + WS_A);
#ifndef PROBE_DUP
#define PROBE_DUP -1
#endif
#ifdef ONLY_ATTN
#define IN(k) (((k) == 4 || (k) == 14) && lo <= (k) && (k) < hi)
#else
#define IN(k) (lo <= (k) && (k) < hi)
#endif
#define REP(k) for (int rep_ = 0; rep_ < (((k) == PROBE_DUP || (PROBE_DUP == 200 && ((k) == 2 || (k) == 5 || (k) == 10))) ? 2 : 1); ++rep_)
#define SEAM(k) do { if ((k) + 1 < hi) { if (hi > 1000) grid.sync(); else xcd_barrier(bar); } } while (0)
    #ifndef NO_PREP
    if (IN(0)) { REP(0) prep_phase(p, lds, 0, (int)blockIdx.x, (int)gridDim.x); SEAM(0); }
#endif
    if (PROBE_DUP == 100) { for (int i_ = 0; i_ < 20; ++i_) xcd_barrier(bar); }
    if (IN(1)) { REP(1) norm_phase(p.in[0], p.in[2], p.in[6], MOD, 0, 1, A, MTOT, nullptr, true); SEAM(1); }
    if (IN(2)) { EpiStoreBf16 E; E.O = (bf16_t*)(ws + WS_P); E.ldc = 2048; E.ss = nullptr; E.invn = 0.f; REP(2) run_gemm(lds, A, 1024, (const bf16_t*)(ws + WS_WIN), MTOT, 2048, 1024, E);
                 { int three = MTOT / 256 * 8 - 2 * (int)gridDim.x; if (three < 0 || three >= (int)gridDim.x) three = 0; prep_phase(p, lds, 2, (int)blockIdx.x - three, (int)gridDim.x - three); }
                 SEAM(2); }
    if (IN(3)) { if (PROBE_DUP == 3) prepL0_phase(p, hi < 1000); prepL0_phase(p, false); SEAM(3); }
    #ifndef NO_DIFF
    if (IN(4)) { diffattn_phase(p, lds, PROBE_DUP == 4 ? 2 : 1);
                 { const int G = (int)gridDim.x; const int vcu = (G % 8 == 0) ? ((int)blockIdx.x % 8) * (G / 8) + (int)blockIdx.x / 8 : (int)blockIdx.x;
                   int third = 576 - 2 * G; if (third < 0 || third >= G) third = 0; prep_phase(p, lds, 4, vcu - third, G - third); }
                 SEAM(4); }
#endif
    if (IN(5)) { EpiResid E; E.baseL = p.in[0]; E.baseC = p.in[2]; E.outL = HL; E.outC = HC; E.gate = MOD + 2 * 1024;
                 REP(5) run_gemm(lds, (const bf16_t*)(ws + WS_MIX), 1024, (const bf16_t*)(ws + WS_WOUT), MTOT, 1024, 1024, E);
                 { int two = MTOT / 256 * 4 - (int)gridDim.x; if (two < 0 || two >= (int)gridDim.x) two = 0; prep_phase(p, lds, 1, (int)blockIdx.x - two, (int)gridDim.x - two); }
                 SEAM(5); }
    if (IN(6)) { REP(6) norm_phase(HL, HC, p.in[7], MOD, 3, 4, A, MTOT); SEAM(6); }
    if (IN(7)) { EpiSwiglu E; E.H = (bf16_t*)(ws + WS_HID); E.Hc = (bf16_t*)(ws + WS_HIDC); REP(7) run_gemm(lds, A, 1024, (const bf16_t*)(ws + WS_WGU0), MTOT, 2 * FFN, 1024, E); SEAM(7); }
    if (IN(8)) { { EpiResid E; E.baseL = HL; E.baseC = HC; E.outL = HL; E.outC = HC; E.gate = MOD + 5 * 1024;
                   run_gemm(lds, (const bf16_t*)(ws + WS_HID), FFN, (const bf16_t*)(ws + WS_WD0), MLAT, 1024, FFN, E); }
                 { const int G = (int)gridDim.x, c = (int)blockIdx.x; EpiPart E; E.gate = MOD + (size_t)8 * 6144 + 5 * 1024;
                   { E.part = (float*)(ws + WS_PART); pg8::Gemm g; g.A = (const bf16_t*)(ws + WS_HIDC); g.Bt = (const bf16_t*)(ws + WS_WD0S); g.M = 2 * MCTX; g.N = 2048; g.K = 768; g.lda = 768;
                     SplitSched S; S.G = G; S.c = c; pg8::gemm_phase<EpiPart, SplitSched, true, true>(lds, g, S, E); }
                   { E.part = (float*)(ws + WS_PART) + (size_t)2 * MCTX * 1024; pg8::Gemm g; g.A = (const bf16_t*)(ws + WS_HIDC) + (size_t)2 * MCTX * 768; g.Bt = (const bf16_t*)(ws + WS_WD0S) + (size_t)2 * 1024 * 768;
                     g.M = 2 * MCTX; g.N = 2048; g.K = 640; g.lda = 640;
                     SplitSched S; S.G = G; S.c = (c - 64 % G + G) % G; pg8::gemm_phase<EpiPart, SplitSched, true, true>(lds, g, S, E); } }
                 SEAM(8); }
    const float* MOD1 = MOD + 9 * 6144;
    if (IN(9)) { norm_phase(HL, HC, p.in[6] + 1024, MOD1, 0, 1, A, MTOT, (const float*)(ws + WS_PART)); SEAM(9); }
    if (IN(10)) { EpiLat E; E.O = (bf16_t*)(ws + WS_CQKV); E.gq = p.in[23]; E.gkv = p.in[26]; E.ssq = (float*)(ws + WS_SS); E.ssk = (float*)(ws + WS_SS) + MTOT; run_gemm(lds, A, 1024, (const bf16_t*)(ws + WS_WDQKV), MTOT, 768, 1024, E); SEAM(10); }
    if (IN(12)) REP(12) { { EpiStoreBf16 E; E.O = (bf16_t*)(ws + WS_QRAW); E.ldc = 1536; E.ss = nullptr; E.invn = 0.f; run_gemm(lds, (const bf16_t*)(ws + WS_CQKV), 768, (const bf16_t*)(ws + WS_WUQ), MLAT, 1536, 384, E); }
                  { EpiKV E; E.KV = (bf16_t*)(ws + WS_KVRAW); E.KR = (bf16_t*)(ws + WS_KRN); E.C = (const bf16_t*)(ws + WS_CQKV); E.ssk = (const float*)(ws + WS_SS) + MTOT; E.kg = p.in[29]; run_gemm(lds, (const bf16_t*)(ws + WS_CQKV) + 384, 768, (const bf16_t*)(ws + WS_WUKV), MTOT, 2048, 256, E, (int)gridDim.x / 2); }
                  } if (IN(12)) { SEAM(12); }
    #ifndef NO_MLA
    if (IN(14)) { mla_phase(p, lds, PROBE_DUP == 14 ? 2 : 1); SEAM(14); }
#endif
    if (IN(15)) { EpiResid E; E.baseL = HL; E.baseC = HC; E.outL = HL; E.outC = HC; E.gate = MOD1 + 2 * 1024;
                  run_gemm(lds, A, 1024, (const bf16_t*)(ws + WS_WMO), MLAT, 1024, 1024, E); SEAM(15); }
    if (IN(16)) { REP(16) norm_phase(HL, HC, p.in[7] + 1024, MOD1, 3, 4, A, MLAT); SEAM(16); }
    if (IN(17)) { EpiSwiglu E; E.H = (bf16_t*)(ws + WS_HID); E.Hc = nullptr; run_gemm(lds, A, 1024, (const bf16_t*)(ws + WS_WGU1), MLAT, 2 * FFN, 1024, E); SEAM(17); }
    if (IN(18)) { EpiResid E; E.baseL = HL; E.baseC = HC; E.outL = HL; E.outC = HC; E.gate = MOD1 + 5 * 1024;
                  run_gemm(lds, (const bf16_t*)(ws + WS_HID), FFN, (const bf16_t*)(ws + WS_WD1), MLAT, 1024, FFN, E); }
#undef IN
#undef SEAM
#undef REP
}

extern "C" void kernel_launch(void* const* d_in, const int* in_sizes, int n_in, void* d_out, int out_size, void* d_ws, size_t ws_size, hipStream_t stream) {
    static int grid = 0;
    if (grid == 0) {
        if (n_in != 31 || out_size != MLAT * DM || ws_size < WS_END) { fprintf(stderr, "kernel_launch: unexpected shapes (n_in %d out %d ws %zu)\n", n_in, out_size, ws_size); grid = -1; return; }
        int dev = 0, cus = 0, per_cu = 0;
        hipGetDevice(&dev);
        hipDeviceGetAttribute(&cus, hipDeviceAttributeMultiprocessorCount, dev);
        if (hipFuncSetAttribute((const void*)fwd_megakernel, hipFuncAttributeMaxDynamicSharedMemorySize, LDS_BYTES) != hipSuccess) { fprintf(stderr, "kernel_launch: hipFuncSetAttribute failed\n"); grid = -1; return; }
        if (hipOccupancyMaxActiveBlocksPerMultiprocessor(&per_cu, (const void*)fwd_megakernel, NTHR, LDS_BYTES) != hipSuccess || per_cu < 1) { fprintf(stderr, "kernel_launch: occupancy query gave %d\n", per_cu); per_cu = 1; }
        (void)hipGetLastError();
        grid = cus * 1;
        if (grid % 8 != 0 || grid <= 0) { fprintf(stderr, "kernel_launch: odd CU count %d\n", cus); }
    }
    if (grid < 0) return;
    Params p{};
    for (int i = 0; i < 31; ++i) p.in[i] = (const float*)d_in[i];
    p.out = (float*)d_out; p.ws = (unsigned char*)d_ws;
    if (hipMemsetAsync((char*)d_ws + WS_BAR, 0, ZERO_BYTES, stream) != hipSuccess) { fprintf(stderr, "kernel_launch: memset failed\n"); return; }
#if ONE_LAUNCH
    p.ph_lo = 0; p.ph_hi = N_PHASES;
    void* args[] = {&p};
    hipError_t e = hipLaunchCooperativeKernel((const void*)fwd_megakernel, dim3(grid), dim3(NTHR), args, LDS_BYTES, stream);
    if (e != hipSuccess) fprintf(stderr, "cooperative launch failed: %s (grid %d)\n", hipGetErrorString(e), grid);
#else
    for (int ph = 0; ph < N_PHASES; ++ph) { p.ph_lo = ph; p.ph_hi = ph + 1; hipLaunchKernelGGL(fwd_megakernel, dim3(grid), dim3(NTHR), LDS_BYTES, stream, p); }
#endif
}
```

```cpp
#include <hip/hip_runtime.h>
#include <hip/hip_cooperative_groups.h>
#include <cstdio>
#include <cstdint>
namespace cg = cooperative_groups;
namespace pg8 {
#define PG8_LAS __attribute__((address_space(3)))
typedef unsigned short bf16_t;
typedef short bf16x8 __attribute__((ext_vector_type(8)));
typedef float f32x4 __attribute__((ext_vector_type(4)));
typedef unsigned u32x4 __attribute__((ext_vector_type(4)));
constexpr int BM = 256, BK = 64, HALF = 128, HTB = HALF * BK * 2  , STAGE_BYTES = 8 * HTB, NXCD = 8, WGM = 8;

__host__ __device__ __forceinline__ int lds_byte(int r, int c) { const int st = (r >> 4) * 2 + (c >> 5), rr = r & 15, cc = c & 31, ob = rr * 64 + cc * 2; return st * 1024 + (ob ^ (((ob >> 9) & 1) << 5)); }
__host__ __device__ __forceinline__ void stage_rc(int b, int& R, int& C) { const int st = b / 1024, sb = b % 1024, swz = sb ^ (((sb >> 9) & 1) << 5); R = (st >> 1) * 16 + swz / 64; C = (st & 1) * 32 + (swz % 64) / 2; }
__host__ __device__ __forceinline__ int perm32(int rho) { const int n = rho >> 4, i = rho & 15; return 8 * (i >> 2) + 4 * n + (i & 3); }

struct Unit { int pm, pn; };
struct Gemm { const bf16_t* A; const bf16_t* Bt; int M, N, K, lda; };

struct StaticOrder {
    int nM, nN, nwg, G, c;
    __host__ __device__ void init(int M, int N, int G_, int c_) { nM = M / BM; nN = N / BM; nwg = nM * nN; G = G_; c = c_; }
    __host__ __device__ bool next(int i, Unit& u) const {
        const long L = (long)i * G + c; if (L >= nwg) return false;
        int wgid = (int)L; { const int q = nwg / NXCD, r = nwg % NXCD, xcd = wgid % NXCD, off = wgid / NXCD; wgid = (xcd < r ? xcd * (q + 1) : r * (q + 1) + (xcd - r) * q) + off; }
        const int nig = WGM * nN, gid = wgid / nig, fm = gid * WGM, gsz = (nM - fm) < WGM ? (nM - fm) : WGM;
        u.pm = fm + ((wgid % nig) % gsz); u.pn = (wgid % nig) / gsz; return true;
    }
    __device__ __forceinline__ void a_ready(const Unit&) const {}
    __device__ __forceinline__ void done(const Unit&) const {}
};
__device__ __forceinline__ unsigned cvt_pk_bf16(float lo, float hi) { unsigned r; asm volatile("v_cvt_pk_bf16_f32 %0, %1, %2" : "=v"(r) : "v"(lo), "v"(hi)); return r; }
template <class Epi, class Sched, bool ALIGN_EPI = false, bool SP2 = false>
__device__ __forceinline__ void gemm_phase(PG8_LAS unsigned char* lds, const Gemm g, const Sched& S, const Epi& E) {
    const int tid = threadIdx.x, wid = __builtin_amdgcn_readfirstlane(tid >> 6), lane = tid & 63, wr = wid >> 2, wc = wid & 3, fr = lane & 15, fq = lane >> 4;
    const int K = g.K, nt = K / BK;
    unsigned voffA[2], voffB[2];
#pragma unroll
    for (int i = 0; i < 2; ++i) { int R, C; stage_rc(tid * 16 + i * 8192, R, C); const int Rb = Epi::PERM ? ((R & ~31) + perm32(R & 31)) : R;
        voffA[i] = (unsigned)(R * g.lda + C) * 2u; voffB[i] = (unsigned)(Rb * K + C) * 2u; }
    const size_t kstep = (size_t)(BK * 2);
    const size_t hstepB = (size_t)HALF * K * 2, hstepA = (size_t)HALF * g.lda * 2;
    const size_t tstepA = 2 * hstepA, tstepB = 2 * hstepB;
    const unsigned ldsw = (unsigned)wid * 1024u;
    const int aoff = lds_byte(wr * 64 + fr, fq * 8), boff = lds_byte(wc * 32 + fr, fq * 8);
#define PG8_SA(b, h) (((b) * 2 + (h)) * HTB)
#define PG8_SB(b, h) ((4 + (b) * 2 + (h)) * HTB)
#define PG8_STAGE(bufoff, gbase, voff) do { _Pragma("unroll") for (int _i = 0; _i < 2; ++_i) \
        __builtin_amdgcn_global_load_lds((const unsigned*)((const char*)(gbase) + (voff)[_i]), (PG8_LAS unsigned*)(lds + (bufoff) + ldsw + _i * 8192), 16, 0, 0); } while (0)
#define PG8_LDA(dst, b, h) do { _Pragma("unroll") for (int m = 0; m < 4; ++m) _Pragma("unroll") for (int k = 0; k < 2; ++k) dst[m][k] = *(const PG8_LAS bf16x8*)(lds + PG8_SA(b, h) + aoff + m * 2048 + k * 1024); } while (0)
#define PG8_LDB(dst, b, h) do { _Pragma("unroll") for (int n = 0; n < 2; ++n) _Pragma("unroll") for (int k = 0; k < 2; ++k) dst[n][k] = *(const PG8_LAS bf16x8*)(lds + PG8_SB(b, h) + boff + n * 2048 + k * 1024); } while (0)
#define PG8_MMA(ai, bj, At, Bt) do { __builtin_amdgcn_s_setprio(1); _Pragma("unroll") for (int m = 0; m < 4; ++m) _Pragma("unroll") for (int n = 0; n < 2; ++n) _Pragma("unroll") for (int k = 0; k < 2; ++k) \
        acc[ai][bj][m][n] = __builtin_amdgcn_mfma_f32_16x16x32_bf16(Bt[n][k], At[m][k], acc[ai][bj][m][n], 0, 0, 0); __builtin_amdgcn_s_setprio(0); } while (0)
#define PG8_WAIT_V(n) asm volatile("s_waitcnt vmcnt(" #n ")" ::: "memory")
#define PG8_WAIT_L(n) asm volatile("s_waitcnt lgkmcnt(" #n ")" ::: "memory")
#define PG8_BAR __builtin_amdgcn_s_barrier()
#define PG8_SCHED __builtin_amdgcn_sched_barrier(0)
    Unit cur, nxt; int ui = 0;
    if (!S.next(0, cur)) return;
    f32x4 acc[2][2][4][2];
#pragma unroll
    for (int a = 0; a < 2; ++a)
#pragma unroll
        for (int b = 0; b < 2; ++b)
#pragma unroll
            for (int m = 0; m < 4; ++m)
#pragma unroll
                for (int n = 0; n < 2; ++n) acc[a][b][m][n] = (f32x4){0.f, 0.f, 0.f, 0.f};
    bf16x8 At[4][2], B0[2][2], B1[2][2];
    const char* cA = (const char*)g.A + (size_t)cur.pm * tstepA; const char* cB = (const char*)g.Bt + (size_t)cur.pn * tstepB;
    S.a_ready(cur);
    if constexpr (SP2) {
        PG8_STAGE(PG8_SB(0, 0), cB, voffB); PG8_STAGE(PG8_SB(0, 1), cB + hstepB, voffB); PG8_STAGE(PG8_SA(0, 0), cA, voffA); PG8_STAGE(PG8_SA(0, 1), cA + hstepA, voffA);
        if (wr == 1) PG8_BAR;
        PG8_WAIT_V(2); PG8_BAR;
        PG8_STAGE(PG8_SB(1, 0), cB + kstep, voffB); PG8_STAGE(PG8_SA(1, 0), cA + kstep, voffA); PG8_STAGE(PG8_SB(1, 1), cB + hstepB + kstep, voffB);
        PG8_WAIT_V(6); PG8_BAR;
    } else {
        PG8_STAGE(PG8_SB(0, 0), cB, voffB); PG8_STAGE(PG8_SA(0, 0), cA, voffA); PG8_STAGE(PG8_SB(0, 1), cB + hstepB, voffB); PG8_STAGE(PG8_SA(0, 1), cA + hstepA, voffA);
        if (wr == 1) PG8_BAR;
        PG8_WAIT_V(4); PG8_BAR;
        PG8_STAGE(PG8_SB(1, 0), cB + kstep, voffB); PG8_STAGE(PG8_SA(1, 0), cA + kstep, voffA); PG8_STAGE(PG8_SB(1, 1), cB + hstepB + kstep, voffB);
        PG8_WAIT_V(6); PG8_BAR;
    }
    for (;;) {
        const bool has_next = S.next(ui + 1, nxt);
        const char* nA = has_next ? (const char*)g.A + (size_t)nxt.pm * tstepA : cA; const char* nB = has_next ? (const char*)g.Bt + (size_t)nxt.pn * tstepB : cB;
        for (int t = 0; t < nt; t += 2) {
            const bool last = (t == nt - 2);
            const char* a1 = cA + (size_t)(t + 1) * kstep;
            const char* a2 = last ? nA : cA + (size_t)(t + 2) * kstep; const char* b2 = last ? nB : cB + (size_t)(t + 2) * kstep;
            const char* a3 = a2 + kstep; const char* b3 = b2 + kstep;
            if (last && has_next) S.a_ready(nxt);
            if constexpr (SP2) {
            PG8_LDB(B0, 0, 0); PG8_LDB(B1, 0, 1); PG8_SCHED; PG8_LDA(At, 0, 0); PG8_STAGE(PG8_SA(1, 1), a1 + hstepA, voffA);
            PG8_WAIT_V(8); PG8_WAIT_L(0); PG8_BAR; PG8_MMA(0, 0, At, B0); PG8_MMA(0, 1, At, B1); PG8_BAR; PG8_SCHED;
            PG8_LDA(At, 0, 1); PG8_STAGE(PG8_SB(0, 0), b2, voffB); PG8_STAGE(PG8_SB(0, 1), b2 + hstepB, voffB); PG8_STAGE(PG8_SA(0, 0), a2, voffA);
            PG8_WAIT_V(8); PG8_WAIT_L(0); PG8_BAR; PG8_MMA(1, 0, At, B0); PG8_MMA(1, 1, At, B1); PG8_BAR; PG8_SCHED;
            PG8_LDB(B0, 1, 0); PG8_LDB(B1, 1, 1); PG8_SCHED; PG8_LDA(At, 1, 0); PG8_STAGE(PG8_SA(0, 1), a2 + hstepA, voffA);
            PG8_WAIT_V(8); PG8_WAIT_L(0); PG8_BAR; PG8_MMA(0, 0, At, B0); PG8_MMA(0, 1, At, B1); PG8_BAR; PG8_SCHED;
            PG8_LDA(At, 1, 1); PG8_STAGE(PG8_SB(1, 0), b3, voffB); PG8_STAGE(PG8_SB(1, 1), b3 + hstepB, voffB); PG8_STAGE(PG8_SA(1, 0), a3, voffA);
            PG8_WAIT_V(8); PG8_WAIT_L(0); PG8_BAR; PG8_MMA(1, 0, At, B0); PG8_MMA(1, 1, At, B1); PG8_BAR; PG8_SCHED;
            } else {
            PG8_LDB(B0, 0, 0); PG8_SCHED; PG8_LDA(At, 0, 0); PG8_STAGE(PG8_SA(1, 1), a1 + hstepA, voffA);
            PG8_WAIT_L(8); PG8_BAR; PG8_WAIT_L(0); PG8_MMA(0, 0, At, B0); PG8_BAR; PG8_SCHED;
            PG8_LDB(B1, 0, 1); PG8_STAGE(PG8_SB(0, 0), b2, voffB);
            PG8_BAR; PG8_WAIT_L(0); PG8_MMA(0, 1, At, B1); PG8_BAR;
            PG8_LDA(At, 0, 1); PG8_STAGE(PG8_SA(0, 0), a2, voffA);
            PG8_BAR; PG8_WAIT_L(0); PG8_MMA(1, 0, At, B0); PG8_BAR; PG8_SCHED;
            PG8_STAGE(PG8_SB(0, 1), b2 + hstepB, voffB);
            PG8_WAIT_V(6); PG8_BAR; PG8_MMA(1, 1, At, B1); PG8_BAR;
            PG8_LDB(B0, 1, 0); PG8_SCHED; PG8_LDA(At, 1, 0); PG8_STAGE(PG8_SA(0, 1), a2 + hstepA, voffA);
            PG8_WAIT_L(8); PG8_BAR; PG8_WAIT_L(0); PG8_MMA(0, 0, At, B0); PG8_BAR; PG8_SCHED;
            PG8_LDB(B1, 1, 1); PG8_STAGE(PG8_SB(1, 0), b3, voffB);
            PG8_BAR; PG8_WAIT_L(0); PG8_MMA(0, 1, At, B1); PG8_BAR;
            PG8_LDA(At, 1, 1); PG8_STAGE(PG8_SA(1, 0), a3, voffA);
            PG8_BAR; PG8_WAIT_L(0); PG8_MMA(1, 0, At, B0); PG8_BAR; PG8_SCHED;
            PG8_STAGE(PG8_SB(1, 1), b3 + hstepB, voffB);
            PG8_WAIT_V(6); PG8_BAR; PG8_MMA(1, 1, At, B1); PG8_BAR;
            }
        }
        if constexpr (ALIGN_EPI) { if (wr == 0) PG8_BAR; }
        if constexpr (!Epi::AFTER_DRAIN) { E(acc, cur, wr, wc, fr, fq); S.done(cur); }
        if (!has_next) break;
#pragma unroll
        for (int a = 0; a < 2; ++a)
#pragma unroll
            for (int b = 0; b < 2; ++b)
#pragma unroll
                for (int m = 0; m < 4; ++m)
#pragma unroll
                    for (int n = 0; n < 2; ++n) acc[a][b][m][n] = (f32x4){0.f, 0.f, 0.f, 0.f};
        cur = nxt; cA = nA; cB = nB; ++ui;
        if constexpr (ALIGN_EPI) { if (wr == 1) PG8_BAR; }
    }
    PG8_WAIT_V(0);
    if constexpr (!ALIGN_EPI) { if (wr == 0) PG8_BAR; }
    PG8_BAR;
    if constexpr (Epi::AFTER_DRAIN) { E.fused(acc, cur, wr, wc, fr, fq, lds, wid, lane); S.done(cur); }
#undef PG8_SA
#undef PG8_SB
#undef PG8_STAGE
#undef PG8_LDA
#undef PG8_LDB
#undef PG8_MMA
#undef PG8_WAIT_V
#undef PG8_WAIT_L
#undef PG8_BAR
#undef PG8_SCHED
}
}
using pg8::bf16_t; using pg8::bf16x8; using pg8::f32x4; using pg8::cvt_pk_bf16; using pg8::Unit;
#define LAS __attribute__((address_space(3)))
typedef unsigned u32x2 __attribute__((ext_vector_type(2)));
typedef unsigned u32x4 __attribute__((ext_vector_type(4)));
typedef short s16x4 __attribute__((ext_vector_type(4)));

#ifndef ONE_LAUNCH
#define ONE_LAUNCH 1
#endif
constexpr int NTHR = 512;
constexpr int DM = 1024, NB = 8, SEQ = 2048, CTX = 256, MLAT = NB * SEQ, MCTX = NB * CTX, MTOT = MLAT + MCTX;
constexpr int FFN = 2816, NKEY = CTX + SEQ;
constexpr float EPS = 1e-6f;
constexpr float LOG2E = 1.4426950408889634f;
constexpr float LOG2_THETA = 13.287712379549449f;
constexpr float LAM_INIT0 = 0.2f;

constexpr size_t WS_MOD   = 0;
constexpr size_t WS_WIN   = 442368;
constexpr size_t WS_WOUT  = WS_WIN   + (size_t)2048 * 1024 * 2;
constexpr size_t WS_WGU0  = WS_WOUT  + (size_t)1024 * 1024 * 2;
constexpr size_t WS_WGU1  = WS_WGU0  + (size_t)5632 * 1024 * 2;
constexpr size_t WS_WD0   = WS_WGU1  + (size_t)5632 * 1024 * 2;
constexpr size_t WS_WD1   = WS_WD0   + (size_t)1024 * 2816 * 2;
constexpr size_t WS_WDQKV = WS_WD1   + (size_t)1024 * 2816 * 2;
constexpr size_t WS_WUQ   = WS_WDQKV + (size_t)768 * 1024 * 2;
constexpr size_t WS_WUKV  = WS_WUQ   + (size_t)1536 * 384 * 2;
constexpr size_t WS_WMO   = WS_WUKV  + (size_t)2048 * 256 * 2;
constexpr size_t WS_HC    = WS_WMO   + (size_t)1024 * 1024 * 2;
constexpr size_t WS_A     = WS_HC    + (size_t)MCTX * 1024 * 4;
constexpr size_t WS_ARENA = WS_A     + (size_t)MTOT * 1024 * 2;
constexpr size_t WS_P     = WS_ARENA;
constexpr size_t WS_MIX   = WS_P     + (size_t)MTOT * 2048 * 2;
constexpr size_t WS_HID   = WS_ARENA;
constexpr size_t WS_HIDC  = WS_HID   + (size_t)MLAT * FFN * 2;
constexpr size_t WS_WD0S  = WS_ARENA + (size_t)120 * 1024 * 1024;
constexpr size_t WS_PART  = WS_ARENA + (size_t)132 * 1024 * 1024;
constexpr size_t WS_CQKV  = WS_ARENA;
constexpr size_t WS_QRAW  = WS_CQKV  + (size_t)MTOT * 768 * 2;
constexpr size_t WS_KVRAW = WS_QRAW  + (size_t)MLAT * 1536 * 2;
constexpr size_t WS_KRN   = WS_KVRAW + (size_t)MTOT * 2048 * 2;
constexpr size_t WS_END   = WS_KRN   + (size_t)MTOT * 512 * 2;
static_assert(WS_END <= (size_t)256 * 1024 * 1024, "workspace too large");
constexpr size_t WS_BAR   = (WS_END + 255) & ~(size_t)255;
constexpr size_t WS_SS    = WS_BAR + 16384;
constexpr size_t ZERO_BYTES = 16384 + (size_t)2 * MTOT * 4;
static_assert(WS_HID + (size_t)MTOT * FFN * 2 <= WS_WD0S && WS_MIX + (size_t)MTOT * 1024 * 2 <= WS_WD0S && WS_WD0S + (size_t)FFN * 1024 * 2 <= WS_PART && WS_PART + (size_t)4 * MCTX * 1024 * 4 <= WS_BAR, "layer-0 split buffers overlap");
static_assert(WS_MIX + (size_t)MTOT * 1024 * 2 <= (size_t)256 * 1024 * 1024, "workspace too large");
static_assert(WS_HID + (size_t)MTOT * FFN * 2 <= (size_t)256 * 1024 * 1024, "workspace too large");

struct Params { const float* in[31]; float* out; unsigned char* ws; int ph_lo, ph_hi; };

__device__ __forceinline__ float bf2f(unsigned short v) { return __uint_as_float((unsigned)v << 16); }
__device__ __forceinline__ void unpack8(const u32x4 w, float (&x)[8]) {
#pragma unroll
    for (int i = 0; i < 4; ++i) { x[2 * i] = __uint_as_float(w[i] << 16); x[2 * i + 1] = __uint_as_float(w[i] & 0xffff0000u); }
}
__device__ __forceinline__ u32x4 pack8(const float (&x)[8]) {
    u32x4 w; w.x = cvt_pk_bf16(x[0], x[1]); w.y = cvt_pk_bf16(x[2], x[3]); w.z = cvt_pk_bf16(x[4], x[5]); w.w = cvt_pk_bf16(x[6], x[7]); return w;
}
template <int CTRL> __device__ __forceinline__ float dpp_f(float v) { return __uint_as_float((unsigned)__builtin_amdgcn_update_dpp(0, (int)__float_as_uint(v), CTRL, 0xF, 0xF, true)); }
__device__ __forceinline__ float sum_x1(float v) { return v + dpp_f<0xB1>(v); }
__device__ __forceinline__ float sum_x2(float v) { return v + dpp_f<0x4E>(v); }
__device__ __forceinline__ float sum_x4(float v) { return v + dpp_f<0x141>(v); }
__device__ __forceinline__ float sum_x8(float v) { return v + dpp_f<0x140>(v); }
__device__ __forceinline__ float sum_x16(float v) { const auto r = __builtin_amdgcn_permlane16_swap(__float_as_uint(v), __float_as_uint(v), false, false); return __uint_as_float(r[0]) + __uint_as_float(r[1]); }
__device__ __forceinline__ float sum_x32(float v) { const auto r = __builtin_amdgcn_permlane32_swap(__float_as_uint(v), __float_as_uint(v), false, false); return __uint_as_float(r[0]) + __uint_as_float(r[1]); }
__device__ __forceinline__ float wave_sum(float v) { return sum_x32(sum_x16(sum_x8(sum_x4(sum_x2(sum_x1(v)))))); }
__device__ __forceinline__ float silu_f(float g) { return g * __builtin_amdgcn_rcpf(1.0f + __expf(-g)); }
__device__ __forceinline__ float rope_freq(int f, float inv_n) { return __builtin_amdgcn_exp2f(-(float)f * inv_n * LOG2_THETA); }
__device__ __forceinline__ void fast_sincos(float ang, float& sn, float& cs) {
    float rev = ang * 0.15915494309189535f; rev = rev - floorf(rev);
    sn = __builtin_amdgcn_sinf(rev); cs = __builtin_amdgcn_cosf(rev);
}

struct EpiStoreBf16 {
    static constexpr bool PERM = true, AFTER_DRAIN = false;
    bf16_t* O; int ldc; const float* ss; float invn;
    __device__ __forceinline__ void operator()(const f32x4 (&acc)[2][2][4][2], const Unit& u, int wr, int wc, int fr, int fq) const {
        const int row0 = u.pm * 256 + wr * 64 + fr, col0 = u.pn * 256 + wc * 32 + 8 * fq;
#pragma unroll
        for (int ai = 0; ai < 2; ++ai)
#pragma unroll
            for (int m = 0; m < 4; ++m) { const int row = row0 + ai * 128 + m * 16; bf16_t* rowp = O + (size_t)row * ldc + col0;
                const float sc = ss ? rsqrtf(ss[row] * invn + EPS) : 1.0f;
#pragma unroll
                for (int bj = 0; bj < 2; ++bj) { const f32x4 v0 = acc[ai][bj][m][0] * sc, v1 = acc[ai][bj][m][1] * sc; u32x4 w;
                    w.x = cvt_pk_bf16(v0[0], v0[1]); w.y = cvt_pk_bf16(v0[2], v0[3]); w.z = cvt_pk_bf16(v1[0], v1[1]); w.w = cvt_pk_bf16(v1[2], v1[3]);
                    *(u32x4*)(rowp + bj * 128) = w; } }
    }
};
struct EpiLat {
    static constexpr bool PERM = true, AFTER_DRAIN = false;
    bf16_t* O; const float* gq; const float* gkv; float* ssq; float* ssk;
    __device__ __forceinline__ void operator()(const f32x4 (&acc)[2][2][4][2], const Unit& u, int wr, int wc, int fr, int fq) const {
        const int row0 = u.pm * 256 + wr * 64 + fr;
#pragma unroll
        for (int bj = 0; bj < 2; ++bj) {
            const int half = u.pn * 2 + bj;
            const int col0 = half * 128 + wc * 32 + 8 * fq;
            f32x4 g0 = {1.f, 1.f, 1.f, 1.f}, g1 = {1.f, 1.f, 1.f, 1.f};
            if (half < 3) { g0 = *(const f32x4*)(gq + col0); g1 = *(const f32x4*)(gq + col0 + 4); }
            else if (half < 5) { g0 = *(const f32x4*)(gkv + col0 - 384); g1 = *(const f32x4*)(gkv + col0 - 380); }
            float* sp = half < 3 ? ssq : ssk;
#pragma unroll
            for (int ai = 0; ai < 2; ++ai)
#pragma unroll
                for (int m = 0; m < 4; ++m) { const int row = row0 + ai * 128 + m * 16;
                    const f32x4 r0 = acc[ai][bj][m][0], r1 = acc[ai][bj][m][1];
                    float s2 = (r0[0] * r0[0] + r0[1] * r0[1]) + (r0[2] * r0[2] + r0[3] * r0[3]) + (r1[0] * r1[0] + r1[1] * r1[1]) + (r1[2] * r1[2] + r1[3] * r1[3]);
                    s2 = sum_x32(sum_x16(s2));
                    if (half < 5 && fq == 0) (void)__hip_atomic_fetch_add(sp + row, s2, __ATOMIC_RELAXED, __HIP_MEMORY_SCOPE_AGENT);
                    const f32x4 v0 = r0 * g0, v1 = r1 * g1; u32x4 w;
                    w.x = cvt_pk_bf16(v0[0], v0[1]); w.y = cvt_pk_bf16(v0[2], v0[3]); w.z = cvt_pk_bf16(v1[0], v1[1]); w.w = cvt_pk_bf16(v1[2], v1[3]);
                    *(u32x4*)(O + (size_t)row * 768 + col0) = w; }
        }
    }
};
struct EpiKV {
    static constexpr bool PERM = true, AFTER_DRAIN = false;
    bf16_t* KV; bf16_t* KR; const bf16_t* C; const float* ssk; const float* kg;
    __device__ __forceinline__ void operator()(const f32x4 (&acc)[2][2][4][2], const Unit& u, int wr, int wc, int fr_, int fq_) const {
        int fr = fr_, fq = fq_; asm volatile("" : "+v"(fr), "+v"(fq));
        const int row0 = u.pm * 256 + wr * 64 + fr, hh = u.pn * 2 + (wc & 1);
        if (wc < 2) {
            constexpr float fr8[8] = {1.0f, 0.31622776601683794f, 0.1f, 0.031622776601683794f, 0.01f, 0.0031622776601683794f, 0.001f, 0.00031622776601683794f};
            const float* kgn = kg + 8 * fq; const float* kgr = kg + 64 + (fq & 1) * 8;
#pragma unroll
            for (int ai = 0; ai < 2; ++ai)
#pragma unroll
                for (int m = 0; m < 4; ++m) { int row = row0 + ai * 128 + m * 16; asm volatile("" : "+v"(row));
                    int z = 0; asm volatile("" : "+v"(z));
                    f32x4 g[2][2]; float gr1[8], gr2[8];
#pragma unroll
                    for (int bj = 0; bj < 2; ++bj)
#pragma unroll
                        for (int n = 0; n < 2; ++n) g[bj][n] = *(const f32x4*)(kgn + z + bj * 32 + 4 * n);
                    { const f32x4 a = *(const f32x4*)(kgr + z), b = *(const f32x4*)(kgr + z + 4), c = *(const f32x4*)(kgr + z + 16), d = *(const f32x4*)(kgr + z + 20);
#pragma unroll
                      for (int e = 0; e < 4; ++e) { gr1[e] = a[e]; gr1[4 + e] = b[e]; gr2[e] = c[e]; gr2[4 + e] = d[e]; } }
                    const float rk = rsqrtf(ssk[row] * (1.0f / 256.0f) + EPS);
                    const bf16_t* rp = C + (size_t)row * 768 + 640 + (fq & 1) * 8;
                    float x1[8], x2[8]; unpack8(*(const u32x4*)rp, x1); unpack8(*(const u32x4*)(rp + 16), x2);
                    f32x4 v[2][2]; float ss = 0.f, sr = 0.f;
#pragma unroll
                    for (int bj = 0; bj < 2; ++bj)
#pragma unroll
                        for (int n = 0; n < 2; ++n) { v[bj][n] = acc[ai][bj][m][n] * rk; ss += (v[bj][n][0] * v[bj][n][0] + v[bj][n][1] * v[bj][n][1]) + (v[bj][n][2] * v[bj][n][2] + v[bj][n][3] * v[bj][n][3]); }
#pragma unroll
                    for (int e = 0; e < 8; ++e) sr += x1[e] * x1[e] + x2[e] * x2[e];
                    ss = sum_x32(sum_x16(ss)); sr = sum_x16(sr);
                    const float rstd = rsqrtf((ss + sr) * (1.0f / 96.0f) + EPS);
                    bf16_t* kp = KV + (size_t)row * 2048 + hh * 128 + 8 * fq;
#pragma unroll
                    for (int bj = 0; bj < 2; ++bj) { const f32x4 a = v[bj][0] * rstd * g[bj][0], b = v[bj][1] * rstd * g[bj][1]; u32x4 w;
                        w.x = cvt_pk_bf16(a[0], a[1]); w.y = cvt_pk_bf16(a[2], a[3]); w.z = cvt_pk_bf16(b[0], b[1]); w.w = cvt_pk_bf16(b[2], b[3]);
                        *(u32x4*)(kp + bj * 32) = w; }
                    const bool lat = row < MLAT; const int t = row & 2047; const float pos = (fq & 1) ? (float)(t & 63) : (float)(t >> 6);
                    float outv[8];
#pragma unroll
                    for (int e = 0; e < 8; ++e) { const float y1 = x1[e] * rstd * gr1[e], y2 = x2[e] * rstd * gr2[e]; float sn = 0.f, cs = 1.f;
                        if (lat) fast_sincos(pos * fr8[e], sn, cs);
                        outv[e] = (fq & 2) ? (y1 * sn + y2 * cs) : (y1 * cs - y2 * sn); }
                    *(u32x4*)(KR + (size_t)row * 512 + hh * 32 + fq * 8) = pack8(outv);
                    if (m & 1) asm volatile("" ::: "memory"); }
        } else {
#pragma unroll
            for (int ai = 0; ai < 2; ++ai)
#pragma unroll
                for (int m = 0; m < 4; ++m) { int row = row0 + ai * 128 + m * 16; asm volatile("" : "+v"(row));
                    const float rk = rsqrtf(ssk[row] * (1.0f / 256.0f) + EPS);
                    bf16_t* vp = KV + (size_t)row * 2048 + hh * 128 + 64 + 8 * fq;
#pragma unroll
                    for (int bj = 0; bj < 2; ++bj) { const f32x4 a = acc[ai][bj][m][0] * rk, b = acc[ai][bj][m][1] * rk; u32x4 w;
                        w.x = cvt_pk_bf16(a[0], a[1]); w.y = cvt_pk_bf16(a[2], a[3]); w.z = cvt_pk_bf16(b[0], b[1]); w.w = cvt_pk_bf16(b[2], b[3]);
                        *(u32x4*)(vp + bj * 32) = w; } }
        }
    }
};
struct EpiResid {
    static constexpr bool PERM = true, AFTER_DRAIN = false;
    const float* baseL; const float* baseC; float* outL; float* outC; const float* gate;
    bool ntbase;
    __device__ __forceinline__ void operator()(const f32x4 (&acc)[2][2][4][2], const Unit& u, int wr, int wc, int fr, int fq) const {
        const int trow = u.pm * 256; const bool lat = trow < MLAT;
        const float* base = lat ? baseL + (size_t)trow * 1024 : baseC + (size_t)(trow - MLAT) * 1024;
        float* out = lat ? outL + (size_t)trow * 1024 : outC + (size_t)(trow - MLAT) * 1024;
        const float* gp = gate + (size_t)(lat ? (trow >> 11) : 8) * 6144;
        const int r0 = wr * 64 + fr, col0 = u.pn * 256 + wc * 32 + 8 * fq;
        f32x4 gv[2][2];
#pragma unroll
        for (int bj = 0; bj < 2; ++bj)
#pragma unroll
            for (int n = 0; n < 2; ++n) gv[bj][n] = *(const f32x4*)(gp + col0 + bj * 128 + n * 4);
#pragma unroll
        for (int ai = 0; ai < 2; ++ai)
#pragma unroll
            for (int m = 0; m < 4; ++m) { const size_t off = (size_t)(r0 + ai * 128 + m * 16) * 1024 + col0;
#pragma unroll
                for (int bj = 0; bj < 2; ++bj)
#pragma unroll
                    for (int n = 0; n < 2; ++n) { const f32x4* bp = (const f32x4*)(base + off + bj * 128 + n * 4); const f32x4 b = ntbase ? __builtin_nontemporal_load(bp) : *bp;
                        *(f32x4*)(out + off + bj * 128 + n * 4) = b + gv[bj][n] * acc[ai][bj][m][n]; } }
    }
};
struct EpiSwiglu {
    static constexpr bool PERM = true, AFTER_DRAIN = false;
    bf16_t* H; bf16_t* Hc;
    __device__ __forceinline__ void operator()(const f32x4 (&acc)[2][2][4][2], const Unit& u, int wr, int wc, int fr, int fq) const {
        const int row0 = u.pm * 256 + wr * 64 + fr, col0 = u.pn * 128 + wc * 32 + 8 * fq;
        bf16_t* base = H + col0; long ldh = FFN; int rsub = 0;
        if (Hc != nullptr && u.pm * 256 >= MLAT) { const int c0 = u.pn * 128; rsub = MLAT;
            if (c0 < 1536) { const int sl = c0 >= 768 ? 1 : 0; ldh = 768; base = Hc + (size_t)sl * MCTX * 768 + (col0 - sl * 768); }
            else { const int sl = c0 >= 2176 ? 1 : 0; ldh = 640; base = Hc + (size_t)2 * MCTX * 768 + (size_t)sl * MCTX * 640 + (col0 - 1536 - sl * 640); } }
#pragma unroll
        for (int ai = 0; ai < 2; ++ai)
#pragma unroll
            for (int m = 0; m < 4; ++m) { bf16_t* rowp = base + (long)(row0 - rsub + ai * 128 + m * 16) * ldh;
                const f32x4 g0 = acc[ai][0][m][0], g1 = acc[ai][0][m][1], u0 = acc[ai][1][m][0], u1 = acc[ai][1][m][1]; u32x4 w;
                w.x = cvt_pk_bf16(silu_f(g0[0]) * u0[0], silu_f(g0[1]) * u0[1]); w.y = cvt_pk_bf16(silu_f(g0[2]) * u0[2], silu_f(g0[3]) * u0[3]);
                w.z = cvt_pk_bf16(silu_f(g1[0]) * u1[0], silu_f(g1[1]) * u1[1]); w.w = cvt_pk_bf16(silu_f(g1[2]) * u1[2], silu_f(g1[3]) * u1[3]);
                *(u32x4*)rowp = w; }
    }
};
struct SplitSched {
    int G, c;
    __device__ __forceinline__ bool next(int i, Unit& u) const {
        const int L = i * G + c; if (L >= 64) return false;
        const int sl = L >> 5, rem = L & 31; u.pm = sl * 8 + (rem & 7); u.pn = sl * 4 + (rem >> 3); return true;
    }
    __device__ __forceinline__ void a_ready(const Unit&) const {}
    __device__ __forceinline__ void done(const Unit&) const {}
};
struct EpiPart {
    static constexpr bool PERM = true, AFTER_DRAIN = false;
    float* part; const float* gate;
    __device__ __forceinline__ void operator()(const f32x4 (&acc)[2][2][4][2], const Unit& u, int wr, int wc, int fr, int fq) const {
        float* out = part + (size_t)(u.pm >> 3) * MCTX * 1024;
        const int r0 = (u.pm & 7) * 256 + wr * 64 + fr, col0 = (u.pn & 3) * 256 + wc * 32 + 8 * fq;
#pragma unroll
        for (int bj = 0; bj < 2; ++bj)
#pragma unroll
            for (int n = 0; n < 2; ++n) { const f32x4 gv = *(const f32x4*)(gate + col0 + bj * 128 + n * 4);
#pragma unroll
                for (int ai = 0; ai < 2; ++ai)
#pragma unroll
                    for (int m = 0; m < 4; ++m) *(f32x4*)(out + (size_t)(r0 + ai * 128 + m * 16) * 1024 + col0 + bj * 128 + n * 4) = gv * acc[ai][bj][m][n]; }
    }
};
template <class Epi>
__device__ __forceinline__ void run_gemm(LAS unsigned char* lds, const bf16_t* A, int lda, const bf16_t* Bt, int M, int N, int K, const Epi& E, int crot = 0) {
    pg8::Gemm g; g.A = A; g.Bt = Bt; g.M = M; g.N = N; g.K = K; g.lda = lda;
    pg8::StaticOrder S; S.init(M, N, (int)gridDim.x, ((int)blockIdx.x + crot) % (int)gridDim.x);
    pg8::gemm_phase<Epi, pg8::StaticOrder, true, true>(lds, g, S, E);
}

__device__ __forceinline__ void adaln_phase(const Params& p, LAS unsigned char* lds, int layer, int gidx, int gsize) {
    LAS float* scond = (LAS float*)lds;
    LAS float* part = (LAS float*)(lds + 9 * 1024 * 4);
    const int tid = threadIdx.x, lane = tid & 63, wid = tid >> 6;
    if (gidx < 0) return;
    const float* c = p.in[1]; const float* cctx = p.in[3]; const float* mw = p.in[4]; const float* mb = p.in[5];
    float* MOD = (float*)(p.ws + WS_MOD);
    if (gidx < 96) {
        for (int i = tid; i < 9 * 1024; i += NTHR) { const int r = i >> 10, k = i & 1023; const float v = r < 8 ? c[r * 1024 + k] : cctx[k]; scond[i] = v / (1.0f + __expf(-v)); }
        __syncthreads();
    }
    for (int u = gidx; u < 96; u += gsize) {
        const int l = layer, n0 = u * 64;
        const float* w = mw + (size_t)l * 1024 * 6144 + n0 + lane;
        float acc[9];
#pragma unroll
        for (int r = 0; r < 9; ++r) acc[r] = 0.f;
#pragma unroll 16
        for (int k = wid * 128; k < wid * 128 + 128; ++k) { const float wv = __builtin_nontemporal_load(w + (size_t)k * 6144);
#pragma unroll
            for (int r = 0; r < 9; ++r) acc[r] += scond[r * 1024 + k] * wv; }
#pragma unroll
        for (int r = 0; r < 9; ++r) part[(wid * 9 + r) * 64 + lane] = acc[r];
        __syncthreads();
        for (int i = tid; i < 576; i += NTHR) { const int r = i >> 6, n = i & 63; float s = mb[l * 6144 + n0 + n];
#pragma unroll
            for (int w8 = 0; w8 < 8; ++w8) s += part[(w8 * 9 + r) * 64 + n];
            MOD[(size_t)(l * 9 + r) * 6144 + n0 + n] = s; }
        __syncthreads();
    }
}
__device__ __forceinline__ void tr_job(const float* src, int K, int N, int lds_, bf16_t* dst, int ldd, int mode, int off, LAS float* tile, int& base, int gidx, int G) {
    const int tid = threadIdx.x;
    if (gidx < 0) return;
    const int tn = (N + 63) >> 6, tk = K >> 6, nt = tn * tk;
    int start = (gidx - base) % G; if (start < 0) start += G;
    const int kk = tid >> 4, nn = (tid & 15) * 4, n = tid >> 3, kc = (tid & 7) * 8;
    for (int t = start; t < nt; t += 2 * G) {
        float4 v[2][2];
#pragma unroll
        for (int q = 0; q < 2; ++q) { const int tq = t + q * G; const bool ok = tq < nt; const int k0 = ok ? (tq / tn) * 64 : 0, n0 = ok ? (tq % tn) * 64 : 0;
#pragma unroll
            for (int h = 0; h < 2; ++h) { v[q][h] = make_float4(0.f, 0.f, 0.f, 0.f);
                if (ok && n0 + nn < N) { const f32x4 t4 = __builtin_nontemporal_load((const f32x4*)(src + (size_t)(k0 + kk + h * 32) * lds_ + n0 + nn)); v[q][h] = make_float4(t4[0], t4[1], t4[2], t4[3]); } } }
#pragma unroll
        for (int q = 0; q < 2; ++q)
#pragma unroll
            for (int h = 0; h < 2; ++h) { LAS float* tp = tile + q * (64 * 65) + (kk + h * 32) * 65 + nn; tp[0] = v[q][h].x; tp[1] = v[q][h].y; tp[2] = v[q][h].z; tp[3] = v[q][h].w; }
        __syncthreads();
#pragma unroll
        for (int q = 0; q < 2; ++q) { const int tq = t + q * G; if (tq >= nt) break; const int k0 = (tq / tn) * 64, n0 = (tq % tn) * 64;
            if (n0 + n < N) { float x[8];
#pragma unroll
                for (int e = 0; e < 8; ++e) x[e] = tile[q * (64 * 65) + (kc + e) * 65 + n];
                const int nn_ = n0 + n; int row = mode == 0 ? nn_ + off : ((nn_ >> 7) * 256 + (nn_ & 127) + off);
                if (mode == 2) { const int head = nn_ >> 7, part = (nn_ >> 6) & 1, d = nn_ & 63;
                    row = (head >> 1) * 256 + (d >> 5) * 128 + ((head & 1) + 2 * part) * 32 + (d & 31); }
                *(u32x4*)(dst + (size_t)row * ldd + k0 + kc) = pack8(x); } }
        __syncthreads();
    }
    base = (base + nt) % G;
}
__device__ __forceinline__ void prep_phase(const Params& p, LAS unsigned char* lds, int part, int gidx, int gsize) {
    if (gidx < 0) return;
    if (part < 2) adaln_phase(p, lds, part, gidx, gsize);
    __syncthreads();
    LAS float* tile = (LAS float*)lds; int base = part < 2 ? 96 % gsize : 0;
    unsigned char* ws = p.ws;
    const int gt = gidx * NTHR + threadIdx.x, GT = gsize * NTHR;
    if (part == 0) {
        tr_job(p.in[11], 1024, 2048, 2048, (bf16_t*)(ws + WS_WIN), 1024, 0, 0, tile, base, gidx, gsize);
        tr_job(p.in[12] + (size_t)512 * 1024, 512, 1024, 1024, (bf16_t*)(ws + WS_WOUT) + 512, 1024, 0, 0, tile, base, gidx, gsize);
        { const float* pw = p.in[13]; const float* ps = p.in[14]; const float* wo = p.in[12]; bf16_t* WoT = (bf16_t*)(ws + WS_WOUT);
          for (int it = gt; it < 4 * 32 * 1024; it += GT) { const int n = it & 1023, gc = it >> 10, g = gc >> 5, c0 = (gc & 31) * 4;
              const float* wop = wo + (size_t)(g * 128) * 1024 + n; const float* psp = ps + g * 128; const float* pwp = pw + (size_t)(g * 128 + c0) * 128;
              float s4[4] = {0.f, 0.f, 0.f, 0.f};
#pragma unroll 1
              for (int e0 = 0; e0 < 128; e0 += 16) { float t[16]; f32x4 a[4][4];
#pragma unroll
                  for (int q = 0; q < 16; ++q) t[q] = wop[(size_t)(e0 + q) * 1024] * psp[e0 + q];
#pragma unroll
                  for (int j = 0; j < 4; ++j)
#pragma unroll
                      for (int q4 = 0; q4 < 4; ++q4) a[j][q4] = *(const f32x4*)(pwp + j * 128 + e0 + q4 * 4);
#pragma unroll
                  for (int j = 0; j < 4; ++j)
#pragma unroll
                      for (int q = 0; q < 16; ++q) s4[j] += a[j][q >> 2][q & 3] * t[q]; }
              u32x2 w; w.x = cvt_pk_bf16(s4[0], s4[1]); w.y = cvt_pk_bf16(s4[2], s4[3]);
              *(u32x2*)(WoT + (size_t)n * 1024 + g * 128 + c0) = w; } }
    } else if (part == 2) {
        tr_job(p.in[8], 1024, FFN, FFN, (bf16_t*)(ws + WS_WGU0), 1024, 1, 0, tile, base, gidx, gsize);
        tr_job(p.in[9], 1024, FFN, FFN, (bf16_t*)(ws + WS_WGU0), 1024, 1, 128, tile, base, gidx, gsize);
        tr_job(p.in[10], FFN, 1024, 1024, (bf16_t*)(ws + WS_WD0), FFN, 0, 0, tile, base, gidx, gsize);
        tr_job(p.in[10], 768, 1024, 1024, (bf16_t*)(ws + WS_WD0S), 768, 0, 0, tile, base, gidx, gsize);
        tr_job(p.in[10] + (size_t)768 * 1024, 768, 1024, 1024, (bf16_t*)(ws + WS_WD0S) + (size_t)1024 * 768, 768, 0, 0, tile, base, gidx, gsize);
        tr_job(p.in[10] + (size_t)1536 * 1024, 640, 1024, 1024, (bf16_t*)(ws + WS_WD0S) + (size_t)2 * 1024 * 768, 640, 0, 0, tile, base, gidx, gsize);
        tr_job(p.in[10] + (size_t)2176 * 1024, 640, 1024, 1024, (bf16_t*)(ws + WS_WD0S) + (size_t)2 * 1024 * 768 + (size_t)1024 * 640, 640, 0, 0, tile, base, gidx, gsize);
    } else {
        tr_job(p.in[8] + (size_t)1024 * FFN, 1024, FFN, FFN, (bf16_t*)(ws + WS_WGU1), 1024, 1, 0, tile, base, gidx, gsize);
        tr_job(p.in[9] + (size_t)1024 * FFN, 1024, FFN, FFN, (bf16_t*)(ws + WS_WGU1), 1024, 1, 128, tile, base, gidx, gsize);
        tr_job(p.in[10] + (size_t)FFN * 1024, FFN, 1024, 1024, (bf16_t*)(ws + WS_WD1), FFN, 0, 0, tile, base, gidx, gsize);
        tr_job(p.in[22], 1024, 384, 384, (bf16_t*)(ws + WS_WDQKV), 1024, 0, 0, tile, base, gidx, gsize);
        tr_job(p.in[25], 1024, 288, 288, (bf16_t*)(ws + WS_WDQKV), 1024, 0, 384, tile, base, gidx, gsize);
        tr_job(p.in[24], 384, 1536, 1536, (bf16_t*)(ws + WS_WUQ), 384, 0, 0, tile, base, gidx, gsize);
        tr_job(p.in[27], 256, 2048, 2048, (bf16_t*)(ws + WS_WUKV), 256, 2, 0, tile, base, gidx, gsize);
        tr_job(p.in[30], 1024, 1024, 1024, (bf16_t*)(ws + WS_WMO), 1024, 0, 0, tile, base, gidx, gsize);
        { u32x4* z = (u32x4*)((bf16_t*)(ws + WS_WDQKV) + (size_t)672 * 1024); const u32x4 zero = {0u, 0u, 0u, 0u};
          for (int i = gt; i < 96 * 1024 / 8; i += GT) z[i] = zero; }
    }
}

__device__ __forceinline__ void norm_phase(const float* __restrict__ srcL, const float* __restrict__ srcC, const float* __restrict__ gn, const float* __restrict__ modl, int csh, int csc, bf16_t* __restrict__ dst, int nrows, const float* __restrict__ part = nullptr, bool nt = false) {
    constexpr int RB = 3;
    const int lane = threadIdx.x & 63, wid = threadIdx.x >> 6, nw = gridDim.x * 8;
    for (int r0 = blockIdx.x * 8 + wid; r0 < nrows; r0 += nw * RB) {
        f32x4 v[RB][4];
#pragma unroll
        for (int u = 0; u < RB; ++u) { int r = r0 + u * nw; r = r < nrows ? r : r0;
            const float* s = r < MLAT ? srcL + (size_t)r * 1024 : srcC + (size_t)(r - MLAT) * 1024;
#pragma unroll
            for (int i = 0; i < 4; ++i) v[u][i] = nt ? __builtin_nontemporal_load((const f32x4*)(s + i * 256 + lane * 4)) : *(const f32x4*)(s + i * 256 + lane * 4);
            if (part != nullptr && r >= MLAT) {
#pragma unroll
                for (int sl = 0; sl < 4; ++sl)
#pragma unroll
                    for (int i = 0; i < 4; ++i) v[u][i] += *(const f32x4*)(part + ((size_t)sl * MCTX + (r - MLAT)) * 1024 + i * 256 + lane * 4); } }
#pragma unroll
        for (int u = 0; u < RB; ++u) { const int r = r0 + u * nw; if (r >= nrows) break;
            float ss = 0.f;
#pragma unroll
            for (int i = 0; i < 4; ++i) ss += v[u][i][0] * v[u][i][0] + v[u][i][1] * v[u][i][1] + v[u][i][2] * v[u][i][2] + v[u][i][3] * v[u][i][3];
            ss = wave_sum(ss);
            const float rstd = rsqrtf(ss * (1.0f / 1024.0f) + EPS);
            const int b = r < MLAT ? (r >> 11) : 8; const float* mp = modl + (size_t)b * 6144;
#pragma unroll
            for (int i = 0; i < 4; ++i) { const int c = i * 256 + lane * 4;
                const f32x4 g4 = *(const f32x4*)(gn + c), sh = *(const f32x4*)(mp + csh * 1024 + c), sc = *(const f32x4*)(mp + csc * 1024 + c);
                const f32x4 y = (v[u][i] * rstd) * g4; const f32x4 a = y * (sc + 1.0f) + sh;
                u32x2 w; w.x = cvt_pk_bf16(a[0], a[1]); w.y = cvt_pk_bf16(a[2], a[3]);
                *(u32x2*)(dst + (size_t)r * 1024 + c) = w; } }
    }
}

__device__ __forceinline__ void prepL0_phase(const Params& p, bool dry) {
    constexpr int RB = 2;
    const int lane = threadIdx.x & 63, wid = threadIdx.x >> 6, nw = gridDim.x * 8;
    bf16_t* P = (bf16_t*)(p.ws + WS_P); bf16_t* MIX = (bf16_t*)(p.ws + WS_MIX);
    const float* kg = p.in[16];
    float kgv[8], fr16[8];
#pragma unroll
    for (int e = 0; e < 8; ++e) { kgv[e] = kg[(lane & 7) * 8 + e]; fr16[e] = rope_freq(((lane & 3) * 8 + e) & 15, 1.0f / 16.0f); }
    const int w = 2 << (lane >> 4);
    for (int r0 = blockIdx.x * 8 + wid; r0 < MTOT; r0 += nw * RB) {
        u32x4 wv[RB][16], kv[RB]; int tt[RB], lo_[RB], hi_[RB];
#pragma unroll
        for (int u = 0; u < RB; ++u) { int r = r0 + u * nw; r = r < MTOT ? r : r0;
            int t, n; if (r < MLAT) { t = r & 2047; n = SEQ; } else { t = (r - MLAT) & 255; n = CTX; }
            const int rowbase = r - t; int lo = t - (w >> 1), hi = lo + w; lo = lo < 0 ? 0 : lo; hi = hi > n ? n : hi;
            tt[u] = t; lo_[u] = lo; hi_[u] = hi;
#pragma unroll
            for (int i = 0; i < 16; ++i) { const int s = t - 8 + i; const bool in = s >= lo && s < hi; const int sc = in ? s : t;
                wv[u][i] = *(const u32x4*)(P + (size_t)(rowbase + sc) * 2048 + lane * 8); }
            kv[u] = *(const u32x4*)(P + (size_t)r * 2048 + 1024 + lane * 8); }
#pragma unroll
        for (int u = 0; u < RB; ++u) { const int r = r0 + u * nw; if (r >= MTOT) break;
            const int t = tt[u]; const bool lat = r < MLAT;
            { float sum[8];
#pragma unroll
              for (int e = 0; e < 8; ++e) sum[e] = 0.f;
#pragma unroll
              for (int i = 0; i < 16; ++i) { const int s = t - 8 + i; const bool in = s >= lo_[u] && s < hi_[u]; float x[8]; unpack8(wv[u][i], x);
#pragma unroll
                  for (int e = 0; e < 8; ++e) sum[e] += in ? x[e] : 0.f; }
              float x[8]; unpack8(wv[u][8], x);
              const float inv = 1.0f / (float)(hi_[u] - lo_[u]);
#pragma unroll
              for (int e = 0; e < 8; ++e) sum[e] = sum[e] * inv - x[e];
              *(u32x4*)(MIX + (size_t)r * 1024 + lane * 8) = pack8(sum); }
            { bf16_t* kp = P + (size_t)r * 2048 + 1024 + lane * 8; float x[8]; unpack8(kv[u], x);
              float ss = 0.f;
#pragma unroll
              for (int e = 0; e < 8; ++e) ss += x[e] * x[e];
              ss = sum_x4(sum_x2(sum_x1(ss)));
              const float rstd = rsqrtf(ss * (1.0f / 64.0f) + EPS);
#pragma unroll
              for (int e = 0; e < 8; ++e) x[e] = x[e] * rstd * kgv[e];
              if (lat) { const float pos = (lane & 2) ? (float)(t & 63) : (float)(t >> 6); const bool hi2 = (lane & 4) != 0;
#pragma unroll
                  for (int e = 0; e < 8; ++e) { const float other = __shfl_xor(x[e], 4); float sn, cs; fast_sincos(pos * fr16[e], sn, cs);
                      x[e] = hi2 ? (other * sn + x[e] * cs) : (x[e] * cs - other * sn); } }
              bf16_t* kd = dry ? (bf16_t*)(p.ws + WS_ARENA + (size_t)120 * 1024 * 1024) + (size_t)r * 512 + lane * 8 : kp;
              *(u32x4*)kd = pack8(x); }
        }
    }
}

#ifndef PROBE_DUP
#define PROBE_DUP -1
#endif
#define ATT_BAR() do { asm volatile("s_waitcnt lgkmcnt(0)" ::: "memory"); __builtin_amdgcn_s_barrier(); asm volatile("" ::: "memory"); } while (0)
struct KVSrc { unsigned ka, kb, v; int lda, offa, ldb, offb, ldv, offv; int ctx_row0, lat_row0; };

template <int DQK, int DV, int CA, bool PAIR>
struct AttnCore {
    static constexpr int KW = PAIR ? 2 * DQK : DQK;
    static constexpr int CK = KW / 8, CV = DV / 8, CPR = CK + CV, TOT = 64 * CPR, NIT = (TOT + NTHR - 1) / NTHR;
    static constexpr int SK = KW * 2 + 16, SV = DV * 2 + 64, VOFF = 64 * SK, BUFB = 64 * SK + 64 * SV;
    static constexpr int NKS = DQK / 32, NVB = DV / 16;
    static constexpr bool ULD = (CA == CK);
    struct Stage { unsigned goff[NIT], gld[ULD ? 1 : NIT]; int soff[NIT]; };

    static __device__ __forceinline__ void setup(const KVSrc& s, Stage& sg) {
        int tidv = (int)threadIdx.x; asm volatile("" : "+v"(tidv));
#pragma unroll
        for (int it = 0; it < NIT; ++it) { int idx = it * NTHR + tidv; idx = idx < TOT ? idx : TOT - 1;
            const int key = idx / CPR, c = idx - key * CPR;
            const bool isk = c < CK;
            const unsigned fa = c < CA ? 1u : 0u, fv = isk ? 0u : 1u, fb = 1u - fa - fv;
            const unsigned base = fa * s.ka + fb * s.kb + fv * s.v; const unsigned ld = fa * (unsigned)s.lda + fb * (unsigned)s.ldb + fv * (unsigned)s.ldv;
            const unsigned col = fa * (unsigned)(s.offa + c * 8) + fb * (unsigned)(s.offb + (c - CA) * 8) + fv * (unsigned)(s.offv + (c - CK) * 8);
            sg.goff[it] = base + ((unsigned)key * ld + col) * 2u; if (!ULD || it == 0) sg.gld[ULD ? 0 : it] = ULD ? (unsigned)s.lda * 2u : ld * 2u;
            sg.soff[it] = isk ? key * SK + c * 16 : VOFF + key * SV + (c - CK) * 16; }
    }
    static __device__ __forceinline__ void gload(const unsigned char* wsb, const KVSrc& s, const Stage& sg, int t, u32x4 (&st)[NIT]) {
        const unsigned rowbase = (unsigned)(t < CTX / 64 ? s.ctx_row0 + t * 64 : s.lat_row0 + (t - CTX / 64) * 64);
#pragma unroll
        for (int it = 0; it < NIT; ++it) st[it] = *(const u32x4*)(wsb + (sg.goff[it] + rowbase * sg.gld[ULD ? 0 : it]));
    }
    static __device__ __forceinline__ void sstore(LAS unsigned char* buf, const Stage& sg, const u32x4 (&st)[NIT]) {
#pragma unroll
        for (int it = 0; it < NIT; ++it) { if ((it + 1) * NTHR <= TOT || it * NTHR + (int)threadIdx.x < TOT) *(LAS u32x4*)(buf + sg.soff[it]) = st[it]; }
    }
    static __device__ __forceinline__ float vmax2(float a, float b) { float r; asm("v_max_f32 %0, %1, %2" : "=v"(r) : "v"(a), "v"(b)); return r; }
    static __device__ __forceinline__ float vmax3(float a, float b, float c) { float r; asm("v_max3_f32 %0, %1, %2, %3" : "=v"(r) : "v"(a), "v"(b), "v"(c)); return r; }
    static __device__ __forceinline__ void softmax_slot(f32x4 (&sq)[4], f32x4 (&o)[NVB][2], int qb, float& m, float& l, bf16x8 (&pf)[2]) {
        float mx = vmax3(sq[0][0], sq[0][1], sq[0][2]); mx = vmax3(mx, sq[0][3], sq[1][0]); mx = vmax3(mx, sq[1][1], sq[1][2]); mx = vmax3(mx, sq[1][3], sq[2][0]);
        mx = vmax3(mx, sq[2][1], sq[2][2]); mx = vmax3(mx, sq[2][3], sq[3][0]); mx = vmax3(mx, sq[3][1], sq[3][2]); mx = vmax2(mx, sq[3][3]);
        { const auto r = __builtin_amdgcn_permlane16_swap(__float_as_uint(mx), __float_as_uint(mx), false, false); mx = vmax2(__uint_as_float(r[0]), __uint_as_float(r[1])); }
        { const auto r = __builtin_amdgcn_permlane32_swap(__float_as_uint(mx), __float_as_uint(mx), false, false); mx = vmax2(__uint_as_float(r[0]), __uint_as_float(r[1])); }
        if (__builtin_amdgcn_ballot_w64(mx > 8.0f) != 0ull) {
            const float delta = vmax2(mx, 0.0f); const float alpha = __builtin_amdgcn_exp2f(-delta); m += delta; l = l * alpha;
#pragma unroll
            for (int vb = 0; vb < NVB; ++vb) o[vb][qb] = o[vb][qb] * alpha;
#pragma unroll
            for (int kb = 0; kb < 4; ++kb) sq[kb] = sq[kb] - delta;
        }
        float ps = 0.f;
#pragma unroll
        for (int kb = 0; kb < 4; ++kb) {
#pragma unroll
            for (int j = 0; j < 4; ++j) { const float pv = __builtin_amdgcn_exp2f(sq[kb][j]); sq[kb][j] = pv; ps += pv; } }
        l += ps;
#pragma unroll
        for (int k2 = 0; k2 < 2; ++k2) { u32x4 w; w.x = cvt_pk_bf16(sq[2 * k2][0], sq[2 * k2][1]); w.y = cvt_pk_bf16(sq[2 * k2][2], sq[2 * k2][3]);
            w.z = cvt_pk_bf16(sq[2 * k2 + 1][0], sq[2 * k2 + 1][1]); w.w = cvt_pk_bf16(sq[2 * k2 + 1][2], sq[2 * k2 + 1][3]);
            pf[k2] = __builtin_bit_cast(bf16x8, w); }
    }
    static __device__ __forceinline__ bf16x8 vread(LAS unsigned char* a) {
        const s16x4 v0 = __builtin_amdgcn_ds_read_tr16_b64_v4i16((LAS s16x4*)a);
        const s16x4 v1 = __builtin_amdgcn_ds_read_tr16_b64_v4i16((LAS s16x4*)(a + 16 * SV));
        return __builtin_shufflevector(v0, v1, 0, 1, 2, 3, 4, 5, 6, 7);
    }
    static __device__ __forceinline__ void tile(LAS unsigned char* buf, const bf16x8 (&qf)[2][NKS], f32x4 (&o)[NVB][2], float (&m)[2], float (&l)[2], int koff, int voff) {
        bf16x8 pf[2][2];
        f32x4 sa[2][4];
#pragma unroll
        for (int kb = 0; kb < 4; ++kb) { sa[0][kb] = (f32x4){-m[0], -m[0], -m[0], -m[0]}; sa[1][kb] = (f32x4){-m[1], -m[1], -m[1], -m[1]}; }
        if constexpr (PAIR) {
#pragma unroll
            for (int hb = 0; hb < 2; ++hb) {
                bf16x8 kf[2][2][NKS];
#pragma unroll
                for (int k = 0; k < 2; ++k)
#pragma unroll
                    for (int qb = 0; qb < 2; ++qb)
#pragma unroll
                        for (int ks = 0; ks < NKS; ++ks) kf[k][qb][ks] = *(const LAS bf16x8*)(buf + koff + (hb * 2 + k) * 16 * SK + qb * DQK * 2 + ks * 64);
                __builtin_amdgcn_sched_barrier(0);
#pragma unroll
                for (int k = 0; k < 2; ++k)
#pragma unroll
                    for (int ks = 0; ks < NKS; ++ks)
#pragma unroll
                        for (int qb = 0; qb < 2; ++qb) sa[qb][hb * 2 + k] = __builtin_amdgcn_mfma_f32_16x16x32_bf16(kf[k][qb][ks], qf[qb][ks], sa[qb][hb * 2 + k], 0, 0, 0);
                __builtin_amdgcn_sched_barrier(0);
            }
        } else {
            bf16x8 kf[4][NKS];
#pragma unroll
            for (int kb = 0; kb < 4; ++kb)
#pragma unroll
                for (int ks = 0; ks < NKS; ++ks) kf[kb][ks] = *(const LAS bf16x8*)(buf + koff + kb * 16 * SK + ks * 64);
            __builtin_amdgcn_sched_barrier(0);
#pragma unroll
            for (int kb = 0; kb < 4; ++kb)
#pragma unroll
                for (int ks = 0; ks < NKS; ++ks) {
                    sa[0][kb] = __builtin_amdgcn_mfma_f32_16x16x32_bf16(kf[kb][ks], qf[0][ks], sa[0][kb], 0, 0, 0);
                    sa[1][kb] = __builtin_amdgcn_mfma_f32_16x16x32_bf16(kf[kb][ks], qf[1][ks], sa[1][kb], 0, 0, 0); }
            __builtin_amdgcn_sched_barrier(0);
        }
        constexpr int VH = NVB > 4 ? 4 : NVB;
        bf16x8 vf[VH];
#pragma unroll
        for (int vb = 0; vb < VH; ++vb) vf[vb] = vread(buf + voff + vb * 32);
        __builtin_amdgcn_sched_barrier(0);
        softmax_slot(sa[0], o, 0, m[0], l[0], pf[0]);
        softmax_slot(sa[1], o, 1, m[1], l[1], pf[1]);
        __builtin_amdgcn_sched_barrier(0);
#pragma unroll
        for (int k2 = 0; k2 < 2; ++k2)
#pragma unroll
            for (int v0 = 0; v0 < NVB; v0 += VH) {
                if (k2 != 0 || v0 != 0) {
#pragma unroll
                    for (int vb = 0; vb < VH; ++vb) vf[vb] = vread(buf + voff + k2 * 32 * SV + (v0 + vb) * 32);
                    __builtin_amdgcn_sched_barrier(0);
                }
#pragma unroll
                for (int vb = 0; vb < VH; ++vb) {
                    o[v0 + vb][0] = __builtin_amdgcn_mfma_f32_16x16x32_bf16(vf[vb], pf[0][k2], o[v0 + vb][0], 0, 0, 0);
                    o[v0 + vb][1] = __builtin_amdgcn_mfma_f32_16x16x32_bf16(vf[vb], pf[1][k2], o[v0 + vb][1], 0, 0, 0); }
                __builtin_amdgcn_sched_barrier(0);
            }
    }
    static constexpr int KBUF = 64 * SK, VBUF = 64 * SV;
    struct StageP { unsigned goff[NIT], gld[ULD ? 1 : NIT]; int soff[NIT]; unsigned kmask; };
    static __device__ __forceinline__ void setup_p(const KVSrc& s, StageP& sg) {
        int tidv = (int)threadIdx.x; asm volatile("" : "+v"(tidv));
        sg.kmask = 0u;
#pragma unroll
        for (int it = 0; it < NIT; ++it) { int idx = it * NTHR + tidv; idx = idx < TOT ? idx : TOT - 1;
            const int key = idx / CPR, c = idx - key * CPR;
            const bool isk = c < CK;
            const unsigned fa = c < CA ? 1u : 0u, fv = isk ? 0u : 1u, fb = 1u - fa - fv;
            const unsigned base = fa * s.ka + fb * s.kb + fv * s.v; const unsigned ld = fa * (unsigned)s.lda + fb * (unsigned)s.ldb + fv * (unsigned)s.ldv;
            const unsigned col = fa * (unsigned)(s.offa + c * 8) + fb * (unsigned)(s.offb + (c - CA) * 8) + fv * (unsigned)(s.offv + (c - CK) * 8);
            sg.goff[it] = base + ((unsigned)key * ld + col) * 2u; if (!ULD || it == 0) sg.gld[ULD ? 0 : it] = ULD ? (unsigned)s.lda * 2u : ld * 2u;
            sg.soff[it] = isk ? key * SK + c * 16 : key * SV + (c - CK) * 16; sg.kmask |= (isk ? 1u : 0u) << it; }
    }
    static __device__ __forceinline__ unsigned rowbase_of(const KVSrc& s, int t) { return (unsigned)(t < CTX / 64 ? s.ctx_row0 + t * 64 : s.lat_row0 + (t - CTX / 64) * 64); }
    static __device__ __forceinline__ void gload_p(const unsigned char* wsb, const KVSrc& s, const StageP& sg, int si, int ntiles, u32x4 (&st)[NIT]) {
        const unsigned rbK = rowbase_of(s, si + 1 < ntiles ? si + 1 : ntiles - 1), rbV = rowbase_of(s, si < 0 ? 0 : si);
#pragma unroll
        for (int it = 0; it < NIT; ++it) { const unsigned rb = ((sg.kmask >> it) & 1u) ? rbK : rbV; st[it] = *(const u32x4*)(wsb + (sg.goff[it] + rb * sg.gld[ULD ? 0 : it])); }
    }
    static __device__ __forceinline__ void sstore_p(LAS unsigned char* lds, const StageP& sg, int kdst, int vdst, const u32x4 (&st)[NIT]) {
#pragma unroll
        for (int it = 0; it < NIT; ++it) { if ((it + 1) * NTHR <= TOT || it * NTHR + (int)threadIdx.x < TOT) *(LAS u32x4*)(lds + sg.soff[it] + (((sg.kmask >> it) & 1u) ? kdst : vdst)) = st[it]; }
    }
    static __device__ __forceinline__ void qk_first(LAS unsigned char* kbuf, const bf16x8 (&qf)[2][NKS], f32x4 (&sa)[2][4], int koff) {
#pragma unroll
        for (int kb = 0; kb < 4; ++kb) { sa[0][kb] = (f32x4){0.f, 0.f, 0.f, 0.f}; sa[1][kb] = (f32x4){0.f, 0.f, 0.f, 0.f}; }
#pragma unroll
        for (int kb = 0; kb < 4; ++kb)
#pragma unroll
            for (int ks = 0; ks < NKS; ++ks) { const bf16x8 kf = *(const LAS bf16x8*)(kbuf + koff + kb * 16 * SK + ks * 64);
                sa[0][kb] = __builtin_amdgcn_mfma_f32_16x16x32_bf16(kf, qf[0][ks], sa[0][kb], 0, 0, 0);
                sa[1][kb] = __builtin_amdgcn_mfma_f32_16x16x32_bf16(kf, qf[1][ks], sa[1][kb], 0, 0, 0); }
    }
    static __device__ __forceinline__ void step_p(LAS unsigned char* kbuf, LAS unsigned char* vbuf, const bf16x8 (&qf)[2][NKS], f32x4 (&o)[NVB][2], float (&m)[2], float (&l)[2],
                                                 f32x4 (&cur)[2][4], f32x4 (&nxt)[2][4], int koff, int voffw) {
        bf16x8 kf[4][NKS];
#pragma unroll
        for (int kb = 0; kb < 4; ++kb)
#pragma unroll
            for (int ks = 0; ks < NKS; ++ks) kf[kb][ks] = *(const LAS bf16x8*)(kbuf + koff + kb * 16 * SK + ks * 64);
        float mx[2];
#pragma unroll
        for (int qb = 0; qb < 2; ++qb) { f32x4 (&sq)[4] = cur[qb];
            float x = vmax3(sq[0][0], sq[0][1], sq[0][2]); x = vmax3(x, sq[0][3], sq[1][0]); x = vmax3(x, sq[1][1], sq[1][2]); x = vmax3(x, sq[1][3], sq[2][0]);
            x = vmax3(x, sq[2][1], sq[2][2]); x = vmax3(x, sq[2][3], sq[3][0]); x = vmax3(x, sq[3][1], sq[3][2]); x = vmax2(x, sq[3][3]);
            { const auto r = __builtin_amdgcn_permlane16_swap(__float_as_uint(x), __float_as_uint(x), false, false); x = vmax2(__uint_as_float(r[0]), __uint_as_float(r[1])); }
            { const auto r = __builtin_amdgcn_permlane32_swap(__float_as_uint(x), __float_as_uint(x), false, false); x = vmax2(__uint_as_float(r[0]), __uint_as_float(r[1])); }
            mx[qb] = x; }
        if (__builtin_amdgcn_ballot_w64(mx[0] > 8.0f || mx[1] > 8.0f) != 0ull) {
#pragma unroll
            for (int qb = 0; qb < 2; ++qb) { const float delta = mx[qb] > 8.0f ? mx[qb] : 0.0f; const float alpha = __builtin_amdgcn_exp2f(-delta); m[qb] += delta; l[qb] *= alpha;
#pragma unroll
                for (int vb = 0; vb < NVB; ++vb) o[vb][qb] = o[vb][qb] * alpha;
#pragma unroll
                for (int kb = 0; kb < 4; ++kb) cur[qb][kb] = cur[qb][kb] - delta; }
        }
        constexpr int VH = NVB > 4 ? 4 : NVB;
        bf16x8 vf[VH];
#pragma unroll
        for (int vb = 0; vb < VH; ++vb) vf[vb] = vread(vbuf + voffw + vb * 32);
        __builtin_amdgcn_sched_barrier(0);
        float ps0 = 0.f, ps1 = 0.f;
#pragma unroll
        for (int kb = 0; kb < 4; ++kb) {
            nxt[0][kb] = (f32x4){-m[0], -m[0], -m[0], -m[0]}; nxt[1][kb] = (f32x4){-m[1], -m[1], -m[1], -m[1]};
#pragma unroll
            for (int ks = 0; ks < NKS; ++ks) {
                nxt[0][kb] = __builtin_amdgcn_mfma_f32_16x16x32_bf16(kf[kb][ks], qf[0][ks], nxt[0][kb], 0, 0, 0);
                nxt[1][kb] = __builtin_amdgcn_mfma_f32_16x16x32_bf16(kf[kb][ks], qf[1][ks], nxt[1][kb], 0, 0, 0); }
#pragma unroll
            for (int j = 0; j < 4; ++j) { const float p0 = __builtin_amdgcn_exp2f(cur[0][kb][j]); cur[0][kb][j] = p0; ps0 += p0;
                                          const float p1 = __builtin_amdgcn_exp2f(cur[1][kb][j]); cur[1][kb][j] = p1; ps1 += p1; }
        }
        l[0] += ps0; l[1] += ps1;
        bf16x8 pf[2][2];
#pragma unroll
        for (int qb = 0; qb < 2; ++qb)
#pragma unroll
            for (int k2 = 0; k2 < 2; ++k2) { u32x4 w; w.x = cvt_pk_bf16(cur[qb][2 * k2][0], cur[qb][2 * k2][1]); w.y = cvt_pk_bf16(cur[qb][2 * k2][2], cur[qb][2 * k2][3]);
                w.z = cvt_pk_bf16(cur[qb][2 * k2 + 1][0], cur[qb][2 * k2 + 1][1]); w.w = cvt_pk_bf16(cur[qb][2 * k2 + 1][2], cur[qb][2 * k2 + 1][3]);
                pf[qb][k2] = __builtin_bit_cast(bf16x8, w); }
        __builtin_amdgcn_sched_barrier(0);
#pragma unroll
        for (int k2 = 0; k2 < 2; ++k2)
#pragma unroll
            for (int v0 = 0; v0 < NVB; v0 += VH) {
                if (k2 != 0 || v0 != 0) {
#pragma unroll
                    for (int vb = 0; vb < VH; ++vb) vf[vb] = vread(vbuf + voffw + k2 * 32 * SV + (v0 + vb) * 32);
                    __builtin_amdgcn_sched_barrier(0);
                }
#pragma unroll
                for (int vb = 0; vb < VH; ++vb) {
                    o[v0 + vb][0] = __builtin_amdgcn_mfma_f32_16x16x32_bf16(vf[vb], pf[0][k2], o[v0 + vb][0], 0, 0, 0);
                    o[v0 + vb][1] = __builtin_amdgcn_mfma_f32_16x16x32_bf16(vf[vb], pf[1][k2], o[v0 + vb][1], 0, 0, 0); }
                __builtin_amdgcn_sched_barrier(0);
            }
    }
    static __device__ __forceinline__ void run_pipe(LAS unsigned char* lds, const unsigned char* wsb, const KVSrc& s, int ntiles, const bf16x8 (&qf)[2][NKS], f32x4 (&o)[NVB][2]) {
        static_assert(!PAIR, "pipelined form is for the shared-K case");
        const int lane = threadIdx.x & 63, l15 = lane & 15, g = lane >> 4;
        float m[2] = {0.f, 0.f}, l[2] = {0.f, 0.f};
#pragma unroll
        for (int vb = 0; vb < NVB; ++vb) { o[vb][0] = (f32x4){0.f, 0.f, 0.f, 0.f}; o[vb][1] = (f32x4){0.f, 0.f, 0.f, 0.f}; }
        StageP sg; setup_p(s, sg);
        u32x4 stA[NIT], stB[NIT];
        LAS unsigned char* K0 = lds; LAS unsigned char* K1 = lds + KBUF; LAS unsigned char* V0 = lds + 2 * KBUF; LAS unsigned char* V1 = lds + 2 * KBUF + VBUF;
        gload_p(wsb, s, sg, -1, ntiles, stB); gload_p(wsb, s, sg, 0, ntiles, stA);
        sstore_p(lds, sg, 0, 2 * KBUF + VBUF, stB); sstore_p(lds, sg, KBUF, 2 * KBUF, stA);
        gload_p(wsb, s, sg, 1, ntiles, stB);
        ATT_BAR();
        const int koff = l15 * SK + g * 16;
        const int voffw = (g * 4 + (l15 >> 2)) * SV + (l15 & 3) * 8;
        f32x4 saA[2][4], saB[2][4];
        qk_first(K0, qf, saA, koff);
#pragma unroll 1
        for (int t = 0; t < ntiles; t += 2) {
            gload_p(wsb, s, sg, t + 2, ntiles, stA);
            step_p(K1, V0, qf, o, m, l, saA, saB, koff, voffw);
            sstore_p(lds, sg, 0, 2 * KBUF + VBUF, stB);
            ATT_BAR();
            gload_p(wsb, s, sg, t + 3, ntiles, stB);
            step_p(K0, V1, qf, o, m, l, saB, saA, koff, voffw);
            sstore_p(lds, sg, KBUF, 2 * KBUF, stA);
            ATT_BAR();
        }
#pragma unroll
        for (int qb = 0; qb < 2; ++qb) { float lt = l[qb]; lt += __shfl_xor(lt, 16); lt += __shfl_xor(lt, 32); const float inv = 1.0f / lt;
#pragma unroll
            for (int vb = 0; vb < NVB; ++vb) o[vb][qb] = o[vb][qb] * inv; }
    }
    static constexpr int KT = 2, TOT2 = KT * TOT, NIT2 = (TOT2 + NTHR - 1) / NTHR, SBUF = KT * BUFB;
    struct Stage2 { unsigned goff[NIT2], gld[ULD ? 1 : NIT2]; int soff[NIT2]; };
    static __device__ __forceinline__ void setup2(const KVSrc& s, Stage2& sg) {
        int tidv = (int)threadIdx.x; asm volatile("" : "+v"(tidv));
#pragma unroll
        for (int it = 0; it < NIT2; ++it) { int idx = it * NTHR + tidv; idx = idx < TOT2 ? idx : TOT2 - 1;
            const int key2 = idx / CPR, c = idx - key2 * CPR, sub = key2 >> 6, key = key2 & 63;
            const bool isk = c < CK;
            const unsigned fa = c < CA ? 1u : 0u, fv = isk ? 0u : 1u, fb = 1u - fa - fv;
            const unsigned base = fa * s.ka + fb * s.kb + fv * s.v; const unsigned ld = fa * (unsigned)s.lda + fb * (unsigned)s.ldb + fv * (unsigned)s.ldv;
            const unsigned col = fa * (unsigned)(s.offa + c * 8) + fb * (unsigned)(s.offb + (c - CA) * 8) + fv * (unsigned)(s.offv + (c - CK) * 8);
            sg.goff[it] = base + ((unsigned)key2 * ld + col) * 2u; if (!ULD || it == 0) sg.gld[ULD ? 0 : it] = ULD ? (unsigned)s.lda * 2u : ld * 2u;
            sg.soff[it] = sub * BUFB + (isk ? key * SK + c * 16 : VOFF + key * SV + (c - CK) * 16); }
    }
    static __device__ __forceinline__ void gload2(const unsigned char* wsb, const KVSrc& s, const Stage2& sg, int sp, u32x4 (&st)[NIT2]) {
        const unsigned rowbase = (unsigned)(sp < CTX / 128 ? s.ctx_row0 + sp * 128 : s.lat_row0 + (sp - CTX / 128) * 128);
#pragma unroll
        for (int it = 0; it < NIT2; ++it) st[it] = *(const u32x4*)(wsb + (sg.goff[it] + rowbase * sg.gld[ULD ? 0 : it]));
    }
    static __device__ __forceinline__ void sstore2(LAS unsigned char* buf, const Stage2& sg, const u32x4 (&st)[NIT2]) {
#pragma unroll
        for (int it = 0; it < NIT2; ++it) { if ((it + 1) * NTHR <= TOT2 || it * NTHR + (int)threadIdx.x < TOT2) *(LAS u32x4*)(buf + sg.soff[it]) = st[it]; }
    }
    typedef float f32x16 __attribute__((ext_vector_type(16)));
    static constexpr int NKS16 = DQK / 16, NVB32 = DV / 32;
    static __device__ __forceinline__ void tile32(LAS unsigned char* buf, const bf16x8 (&qf)[NKS16], f32x16 (&o)[NVB32], float& m, float& l, int koff, int voff) {
        f32x16 sa[2];
#pragma unroll
        for (int kb = 0; kb < 2; ++kb)
#pragma unroll
            for (int r = 0; r < 16; ++r) sa[kb][r] = -m;
#pragma unroll
        for (int kb = 0; kb < 2; ++kb) {
            bf16x8 kf[NKS16];
#pragma unroll
            for (int ks = 0; ks < NKS16; ++ks) kf[ks] = *(const LAS bf16x8*)(buf + koff + kb * 32 * SK + ks * 32);
            __builtin_amdgcn_sched_barrier(0);
#pragma unroll
            for (int ks = 0; ks < NKS16; ++ks) sa[kb] = __builtin_amdgcn_mfma_f32_32x32x16_bf16(kf[ks], qf[ks], sa[kb], 0, 0, 0);
            __builtin_amdgcn_sched_barrier(0);
        }
        bf16x8 vf[2][NVB32];
#pragma unroll
        for (int s2 = 0; s2 < 2; ++s2)
#pragma unroll
            for (int vb = 0; vb < NVB32; ++vb) vf[s2][vb] = vread32(buf + voff + (s2 * 16) * SV + vb * 64);
        __builtin_amdgcn_sched_barrier(0);
        float mx = vmax3(sa[0][0], sa[0][1], sa[0][2]);
#pragma unroll
        for (int r = 3; r < 15; r += 2) mx = vmax3(mx, sa[0][r], sa[0][r + 1]);
        mx = vmax2(mx, sa[0][15]);
#pragma unroll
        for (int r = 0; r < 16; r += 2) mx = vmax3(mx, sa[1][r], sa[1][r + 1]);
        { const auto rr = __builtin_amdgcn_permlane32_swap(__float_as_uint(mx), __float_as_uint(mx), false, false); mx = vmax2(__uint_as_float(rr[0]), __uint_as_float(rr[1])); }
        if (__builtin_amdgcn_ballot_w64(mx > 8.0f) != 0ull) {
            const float delta = vmax2(mx, 0.0f); const float alpha = __builtin_amdgcn_exp2f(-delta); m += delta; l = l * alpha;
#pragma unroll
            for (int vb = 0; vb < NVB32; ++vb) o[vb] = o[vb] * alpha;
#pragma unroll
            for (int kb = 0; kb < 2; ++kb) sa[kb] = sa[kb] - delta;
        }
        float ps = 0.f;
#pragma unroll
        for (int kb = 0; kb < 2; ++kb)
#pragma unroll
            for (int r = 0; r < 16; ++r) { const float pv = __builtin_amdgcn_exp2f(sa[kb][r]); sa[kb][r] = pv; ps += pv; }
        l += ps;
        bf16x8 pf[2][2];
#pragma unroll
        for (int kb = 0; kb < 2; ++kb)
#pragma unroll
            for (int s2 = 0; s2 < 2; ++s2) { u32x4 w; w.x = cvt_pk_bf16(sa[kb][8 * s2 + 0], sa[kb][8 * s2 + 1]); w.y = cvt_pk_bf16(sa[kb][8 * s2 + 2], sa[kb][8 * s2 + 3]);
                w.z = cvt_pk_bf16(sa[kb][8 * s2 + 4], sa[kb][8 * s2 + 5]); w.w = cvt_pk_bf16(sa[kb][8 * s2 + 6], sa[kb][8 * s2 + 7]);
                pf[kb][s2] = __builtin_bit_cast(bf16x8, w); }
        __builtin_amdgcn_sched_barrier(0);
#pragma unroll
        for (int kb = 0; kb < 2; ++kb) {
            if (kb == 1) {
#pragma unroll
                for (int s2 = 0; s2 < 2; ++s2)
#pragma unroll
                    for (int vb = 0; vb < NVB32; ++vb) vf[s2][vb] = vread32(buf + voff + (32 + s2 * 16) * SV + vb * 64);
                __builtin_amdgcn_sched_barrier(0);
            }
#pragma unroll
            for (int s2 = 0; s2 < 2; ++s2)
#pragma unroll
                for (int vb = 0; vb < NVB32; ++vb) o[vb] = __builtin_amdgcn_mfma_f32_32x32x16_bf16(vf[s2][vb], pf[kb][s2], o[vb], 0, 0, 0);
            __builtin_amdgcn_sched_barrier(0);
        }
    }
    static __device__ __forceinline__ bf16x8 vread32(LAS unsigned char* a) {
        const s16x4 v0 = __builtin_amdgcn_ds_read_tr16_b64_v4i16((LAS s16x4*)a);
        const s16x4 v1 = __builtin_amdgcn_ds_read_tr16_b64_v4i16((LAS s16x4*)(a + 8 * SV));
        return __builtin_shufflevector(v0, v1, 0, 1, 2, 3, 4, 5, 6, 7);
    }
    static __device__ __forceinline__ void run2_32(LAS unsigned char* lds, const unsigned char* wsb, const KVSrc& s, int ntiles, const bf16x8 (&qf)[NKS16], f32x16 (&o)[NVB32], int kcol = 0) {
        const int lane = threadIdx.x & 63, l31 = lane & 31, hi = lane >> 5, li = lane & 15, nsup = ntiles >> 1;
        float m = 0.f, l = 0.f;
#pragma unroll
        for (int vb = 0; vb < NVB32; ++vb)
#pragma unroll
            for (int r = 0; r < 16; ++r) o[vb][r] = 0.f;
        Stage2 sg; setup2(s, sg);
        u32x4 st[NIT2];
        gload2(wsb, s, sg, 0, st); sstore2(lds, sg, st); ATT_BAR();
        const int koff = l31 * SK + hi * 16 + kcol;
        const int voff = VOFF + (4 * hi + (li >> 2)) * SV + (((lane >> 4) & 1) * 16 + (li & 3) * 4) * 2;
#pragma unroll 1
        for (int sp = 0; sp < nsup; sp += 2) {
            gload2(wsb, s, sg, sp + 1, st);
            tile32(lds, qf, o, m, l, koff, voff);
            tile32(lds + BUFB, qf, o, m, l, koff, voff);
            sstore2(lds + SBUF, sg, st);
            ATT_BAR();
            gload2(wsb, s, sg, sp + 2 < nsup ? sp + 2 : nsup - 1, st);
            tile32(lds + SBUF, qf, o, m, l, koff, voff);
            tile32(lds + SBUF + BUFB, qf, o, m, l, koff, voff);
            sstore2(lds, sg, st);
            ATT_BAR();
        }
        { const auto rr = __builtin_amdgcn_permlane32_swap(__float_as_uint(l), __float_as_uint(l), false, false); l = __uint_as_float(rr[0]) + __uint_as_float(rr[1]); }
        const float inv = 1.0f / l;
#pragma unroll
        for (int vb = 0; vb < NVB32; ++vb) o[vb] = o[vb] * inv;
    }
    static __device__ __forceinline__ void run2(LAS unsigned char* lds, const unsigned char* wsb, const KVSrc& s, int ntiles, const bf16x8 (&qf)[2][NKS], f32x4 (&o)[NVB][2]) {
        const int lane = threadIdx.x & 63, l15 = lane & 15, g = lane >> 4, nsup = ntiles >> 1;
        float m[2] = {0.f, 0.f}, l[2] = {0.f, 0.f};
#pragma unroll
        for (int vb = 0; vb < NVB; ++vb) { o[vb][0] = (f32x4){0.f, 0.f, 0.f, 0.f}; o[vb][1] = (f32x4){0.f, 0.f, 0.f, 0.f}; }
        Stage2 sg; setup2(s, sg);
        u32x4 st[NIT2];
        gload2(wsb, s, sg, 0, st); sstore2(lds, sg, st); ATT_BAR();
        const int koff = l15 * SK + g * 16;
        const int voff = VOFF + (g * 4 + (l15 >> 2)) * SV + (l15 & 3) * 8;
#pragma unroll 1
        for (int sp = 0; sp < nsup; sp += 2) {
            gload2(wsb, s, sg, sp + 1, st);
            tile(lds, qf, o, m, l, koff, voff);
            tile(lds + BUFB, qf, o, m, l, koff, voff);
            sstore2(lds + SBUF, sg, st);
            ATT_BAR();
            gload2(wsb, s, sg, sp + 2 < nsup ? sp + 2 : nsup - 1, st);
            tile(lds + SBUF, qf, o, m, l, koff, voff);
            tile(lds + SBUF + BUFB, qf, o, m, l, koff, voff);
            sstore2(lds, sg, st);
            ATT_BAR();
        }
#pragma unroll
        for (int qb = 0; qb < 2; ++qb) { float lt = l[qb]; lt += __shfl_xor(lt, 16); lt += __shfl_xor(lt, 32); const float inv = 1.0f / lt;
#pragma unroll
            for (int vb = 0; vb < NVB; ++vb) o[vb][qb] = o[vb][qb] * inv; }
    }
    static __device__ __forceinline__ void run(LAS unsigned char* lds, const unsigned char* wsb, const KVSrc& s, int ntiles, const bf16x8 (&qf)[2][NKS], f32x4 (&o)[NVB][2]) {
        const int lane = threadIdx.x & 63, l15 = lane & 15, g = lane >> 4;
        float m[2] = {0.f, 0.f}, l[2] = {0.f, 0.f};
#pragma unroll
        for (int vb = 0; vb < NVB; ++vb) { o[vb][0] = (f32x4){0.f, 0.f, 0.f, 0.f}; o[vb][1] = (f32x4){0.f, 0.f, 0.f, 0.f}; }
        Stage sg; setup(s, sg);
        u32x4 stA[NIT], stB[NIT];
        gload(wsb, s, sg, 0, stA); gload(wsb, s, sg, 1, stB); sstore(lds, sg, stA); ATT_BAR();
        const int koff = l15 * SK + g * 16;
        const int voff = VOFF + (g * 4 + (l15 >> 2)) * SV + (l15 & 3) * 8;
#pragma unroll 1
        for (int t = 0; t < ntiles; t += 2) {
            gload(wsb, s, sg, t + 2 < ntiles ? t + 2 : ntiles - 1, stA);
            tile(lds, qf, o, m, l, koff, voff);
#if PROBE_DUP == 300
            if (!PAIR) tile(lds, qf, o, m, l, koff, voff);
#endif
            sstore(lds + BUFB, sg, stB);
            ATT_BAR();
            gload(wsb, s, sg, t + 3 < ntiles ? t + 3 : ntiles - 1, stB);
            tile(lds + BUFB, qf, o, m, l, koff, voff);
#if PROBE_DUP == 300
            if (!PAIR) tile(lds + BUFB, qf, o, m, l, koff, voff);
#endif
            sstore(lds, sg, stA);
            ATT_BAR();
        }
#pragma unroll
        for (int qb = 0; qb < 2; ++qb) { float lt = l[qb]; lt += __shfl_xor(lt, 16); lt += __shfl_xor(lt, 32); const float inv = 1.0f / lt;
#pragma unroll
            for (int vb = 0; vb < NVB; ++vb) o[vb][qb] = o[vb][qb] * inv; }
    }
};

__device__ __forceinline__ void diffattn_phase(const Params& p, LAS unsigned char* lds, int nrep) {
    typedef AttnCore<64, 128, 16, true> AC;
    const int tid = threadIdx.x, lane = tid & 63, wid = tid >> 6, rg = wid & 3, jw = wid >> 2, l31 = lane & 31, hi = lane >> 5, G = gridDim.x;
    const int vcu = (G % 8 == 0) ? ((int)blockIdx.x % 8) * (G / 8) + (int)blockIdx.x / 8 : (int)blockIdx.x;
    const bf16_t* P = (const bf16_t*)(p.ws + WS_P); bf16_t* MIX = (bf16_t*)(p.ws + WS_MIX);
    float lam;
    { const float a = wave_sum(p.in[17][lane] * p.in[18][lane]), b = wave_sum(p.in[19][lane] * p.in[20][lane]); lam = __expf(a) - __expf(b) + LAM_INIT0; }
    const float* qg = p.in[15]; const float* sg = p.in[21];
    const float qscale = 0.125f * LOG2E;
#pragma unroll 1
    for (int uu = vcu; uu < 576 * nrep; uu += G) {
        const int u = uu % 576;
        int b, h, qrow0, ntiles, pos0; const bool lat = u < 512;
        if (lat) { const int qblk = u & 15; h = (u >> 4) & 3; b = u >> 6; pos0 = qblk * 128 + rg * 32; qrow0 = b * SEQ + pos0; ntiles = NKEY / 64; }
        else { const int uc = u - 512; const int qblk = uc & 1; h = (uc >> 1) & 3; b = uc >> 3; pos0 = qblk * 128 + rg * 32; qrow0 = MLAT + b * CTX + pos0; ntiles = CTX / 64; }
        bf16x8 qf[4];
        {
            int hq = hi, zq = 0; asm volatile("" : "+v"(hq), "+v"(zq));
            const bf16_t* qp = P + (size_t)(qrow0 + l31) * 2048 + 512 + (h * 2 + jw) * 64 + hq * 8;
            float x[4][8]; float ss = 0.f;
#pragma unroll
            for (int ks = 0; ks < 4; ++ks) { unpack8(*(const u32x4*)(qp + ks * 16), x[ks]);
#pragma unroll
                for (int e = 0; e < 8; ++e) ss += x[ks][e] * x[ks][e]; }
            ss = sum_x32(ss);
            const float rstd = rsqrtf(ss * (1.0f / 64.0f) + EPS) * qscale;
#pragma unroll
            for (int ks = 0; ks < 4; ++ks)
#pragma unroll
                for (int e = 0; e < 8; ++e) x[ks][e] = x[ks][e] * rstd * qg[ks * 16 + hq * 8 + e];
            if (lat) { const int pos = pos0 + l31; const float prow = (float)(pos >> 6), pcol = (float)(pos & 63);
#pragma unroll
                for (int e = 0; e < 8; ++e) { const float fq = rope_freq(hq * 8 + e + zq, 1.0f / 16.0f); float sn, cs;
                    fast_sincos(prow * fq, sn, cs); { const float a = x[0][e], c = x[2][e]; x[0][e] = a * cs - c * sn; x[2][e] = a * sn + c * cs; }
                    fast_sincos(pcol * fq, sn, cs); { const float a = x[1][e], c = x[3][e]; x[1][e] = a * cs - c * sn; x[3][e] = a * sn + c * cs; } } }
#pragma unroll
            for (int ks = 0; ks < 4; ++ks) qf[ks] = __builtin_bit_cast(bf16x8, pack8(x[ks]));
        }
        KVSrc s; s.ka = (unsigned)WS_P; s.lda = 2048; s.offa = 1024 + h * 128; s.kb = (unsigned)WS_P; s.ldb = 2048; s.offb = 0; s.v = (unsigned)WS_P; s.ldv = 2048; s.offv = 1536 + h * 128;
        s.ctx_row0 = MLAT + b * CTX; s.lat_row0 = b * SEQ;
        AC::f32x16 o[4];
        AC::run2_32(lds, p.ws, s, ntiles, qf, o, jw * 128);
        LAS float* xch = (LAS float*)lds + rg * 4096 + lane;
        if (jw == 1) {
#pragma unroll
            for (int vb = 0; vb < 4; ++vb)
#pragma unroll
                for (int r = 0; r < 16; ++r) xch[(vb * 16 + r) * 64] = o[vb][r];
        }
        ATT_BAR();
        if (jw == 0) {
            float ss = 0.f;
#pragma unroll
            for (int vb = 0; vb < 4; ++vb)
#pragma unroll
                for (int r = 0; r < 16; ++r) { const float d = o[vb][r] - xch[(vb * 16 + r) * 64] * lam; o[vb][r] = d; ss += d * d; }
            ss = sum_x32(ss);
            const float rstd = rsqrtf(ss * (1.0f / 128.0f) + EPS) * (1.0f - LAM_INIT0);
            bf16_t* op = MIX + (size_t)(qrow0 + l31) * 1024 + 512 + h * 128 + 4 * hi;
#pragma unroll
            for (int vb = 0; vb < 4; ++vb)
#pragma unroll
                for (int r4 = 0; r4 < 4; ++r4) { const f32x4 gg = *(const f32x4*)(sg + vb * 32 + r4 * 8 + 4 * hi);
                    u32x2 w; w.x = cvt_pk_bf16(o[vb][4 * r4 + 0] * rstd * gg[0], o[vb][4 * r4 + 1] * rstd * gg[1]); w.y = cvt_pk_bf16(o[vb][4 * r4 + 2] * rstd * gg[2], o[vb][4 * r4 + 3] * rstd * gg[3]);
                    *(u32x2*)(op + vb * 32 + r4 * 8) = w; }
        }
        ATT_BAR();
    }
}

__device__ __forceinline__ void latnorm_phase(const Params& p, bool dry) {
    constexpr int RB = 3;
    const int lane = threadIdx.x & 63, wid = threadIdx.x >> 6, nw = gridDim.x * 8;
    bf16_t* C = (bf16_t*)(p.ws + WS_CQKV); const float* gq = p.in[23]; const float* gkv = p.in[26];
    const int lq = lane < 48 ? lane : 0, lk = lane < 32 ? lane : 0;
    float gqv[8], gkvv[8];
#pragma unroll
    for (int e = 0; e < 8; ++e) { gqv[e] = gq[lq * 8 + e]; gkvv[e] = gkv[lk * 8 + e]; }
    for (int r0 = blockIdx.x * 8 + wid; r0 < MTOT; r0 += nw * RB) {
        u32x4 wq[RB], wk[RB];
#pragma unroll
        for (int u = 0; u < RB; ++u) { int r = r0 + u * nw; r = r < MTOT ? r : r0; const bf16_t* rp = C + (size_t)r * 768;
            wq[u] = *(const u32x4*)(rp + lq * 8); wk[u] = *(const u32x4*)(rp + 384 + lk * 8); }
#pragma unroll
        for (int u = 0; u < RB; ++u) { const int r = r0 + u * nw; if (r >= MTOT) break;
            bf16_t* rp = C + (size_t)r * 768; bf16_t* wp = dry ? (bf16_t*)(p.ws + WS_KVRAW) + (size_t)r * 768 : rp;
            float xq[8], xk[8]; unpack8(wq[u], xq); unpack8(wk[u], xk);
            float sq = 0.f, sk = 0.f;
#pragma unroll
            for (int e = 0; e < 8; ++e) { sq += xq[e] * xq[e]; sk += xk[e] * xk[e]; }
            sq = wave_sum(lane < 48 ? sq : 0.f); sk = wave_sum(lane < 32 ? sk : 0.f);
            const float rq = rsqrtf(sq * (1.0f / 384.0f) + EPS), rk = rsqrtf(sk * (1.0f / 256.0f) + EPS);
#pragma unroll
            for (int e = 0; e < 8; ++e) { xq[e] = xq[e] * rq * gqv[e]; xk[e] = xk[e] * rk * gkvv[e]; }
            if (lane < 48) *(u32x4*)(wp + lane * 8) = pack8(xq);
            if (lane < 32) *(u32x4*)(wp + 384 + lane * 8) = pack8(xk); }
    }
}
__device__ __forceinline__ void kprepL1_phase(const Params& p, bool dry) {
    constexpr int RB = 3;
    const int lane = threadIdx.x & 63, wid = threadIdx.x >> 6, h = lane >> 2, part = lane & 3, nw = gridDim.x * 8;
    bf16_t* KV = (bf16_t*)(p.ws + WS_KVRAW); const bf16_t* C = (const bf16_t*)(p.ws + WS_CQKV); bf16_t* KR = (bf16_t*)(p.ws + WS_KRN);
    const float* kg = p.in[29];
    float g0[8], g1[8], gr1[8], gr2[8], fr8[8];
#pragma unroll
    for (int e = 0; e < 8; ++e) { g0[e] = kg[part * 16 + e]; g1[e] = kg[part * 16 + 8 + e]; gr1[e] = kg[64 + (part & 1) * 8 + e]; gr2[e] = kg[80 + (part & 1) * 8 + e]; fr8[e] = rope_freq(e, 1.0f / 8.0f); }
    for (int r0 = blockIdx.x * 8 + wid; r0 < MTOT; r0 += nw * RB) {
        u32x4 wa[RB], wb[RB], w1[RB], w2[RB];
#pragma unroll
        for (int u = 0; u < RB; ++u) { int r = r0 + u * nw; r = r < MTOT ? r : r0;
            const bf16_t* kp = KV + (size_t)r * 2048 + h * 128 + part * 16; const bf16_t* rp = C + (size_t)r * 768 + 640 + (part & 1) * 8;
            wa[u] = *(const u32x4*)kp; wb[u] = *(const u32x4*)(kp + 8); w1[u] = *(const u32x4*)rp; w2[u] = *(const u32x4*)(rp + 16); }
#pragma unroll
        for (int u = 0; u < RB; ++u) { const int r = r0 + u * nw; if (r >= MTOT) break;
            bf16_t* kp = KV + (size_t)r * 2048 + h * 128 + part * 16;
            float a[8], b[8], x1[8], x2[8];
            unpack8(wa[u], a); unpack8(wb[u], b); unpack8(w1[u], x1); unpack8(w2[u], x2);
            float ss = 0.f, sr = 0.f;
#pragma unroll
            for (int e = 0; e < 8; ++e) { ss += a[e] * a[e] + b[e] * b[e]; sr += x1[e] * x1[e] + x2[e] * x2[e]; }
            ss = sum_x2(sum_x1(ss)); sr = sum_x1(sr);
            const float rstd = rsqrtf((ss + sr) * (1.0f / 96.0f) + EPS);
#pragma unroll
            for (int e = 0; e < 8; ++e) { a[e] = a[e] * rstd * g0[e]; b[e] = b[e] * rstd * g1[e]; }
            { bf16_t* kd = dry ? (bf16_t*)(p.ws + WS_A) + (size_t)r * 1024 + h * 64 + part * 16 : kp; *(u32x4*)kd = pack8(a); *(u32x4*)(kd + 8) = pack8(b); }
            const bool lat = r < MLAT; const int t = r & 2047; const float pos = (part & 1) ? (float)(t & 63) : (float)(t >> 6);
            float outv[8];
#pragma unroll
            for (int e = 0; e < 8; ++e) { const float y1 = x1[e] * rstd * gr1[e], y2 = x2[e] * rstd * gr2[e]; float sn = 0.f, cs = 1.f;
                if (lat) fast_sincos(pos * fr8[e], sn, cs);
                outv[e] = (part & 2) ? (y1 * sn + y2 * cs) : (y1 * cs - y2 * sn); }
            *(u32x4*)(KR + (size_t)r * 512 + h * 32 + part * 8) = pack8(outv); }
    }
}

__device__ __forceinline__ void mla_phase(const Params& p, LAS unsigned char* lds, int nrep) {
    typedef AttnCore<96, 64, 8, false> AC;
    const int tid = threadIdx.x, lane = tid & 63, wid = tid >> 6, l15 = lane & 15, g = lane >> 4, G = gridDim.x;
    const int vcu = (G % 8 == 0) ? ((int)blockIdx.x % 8) * (G / 8) + (int)blockIdx.x / 8 : (int)blockIdx.x;
    const bf16_t* Q = (const bf16_t*)(p.ws + WS_QRAW); const bf16_t* KV = (const bf16_t*)(p.ws + WS_KVRAW); const bf16_t* KR = (const bf16_t*)(p.ws + WS_KRN);
    bf16_t* O = (bf16_t*)(p.ws + WS_A);
    const float* qg = p.in[28];
    const float qscale = 0.10206207261596577f * LOG2E;
#pragma unroll 1
    for (int uu = vcu; uu < 1024 * nrep; uu += G) {
        const int u = uu & 1023;
        const int qblk = u & 7, h = (u >> 3) & 15, b = u >> 7;
        const int pos0 = qblk * 256 + wid * 32, qrow0 = b * SEQ + pos0;
        const int l31 = lane & 31, hi = lane >> 5;
        bf16x8 qf[6];
        {
            int hq = hi, zq = 0; asm volatile("" : "+v"(hq), "+v"(zq));
            const bf16_t* qp = Q + (size_t)(qrow0 + l31) * 1536 + h * 96 + hq * 8;
            float x[6][8]; float ss = 0.f;
#pragma unroll
            for (int ks = 0; ks < 6; ++ks) { unpack8(*(const u32x4*)(qp + ks * 16), x[ks]);
#pragma unroll
                for (int e = 0; e < 8; ++e) ss += x[ks][e] * x[ks][e]; }
            ss = sum_x32(ss);
            const float epsq = EPS * (((const float*)(p.ws + WS_SS))[qrow0 + l31] * (1.0f / 384.0f) + EPS);
            const float rstd = rsqrtf(ss * (1.0f / 96.0f) + epsq);
            const int pos = pos0 + l31; const float pf_ = hq ? (float)(pos & 63) : (float)(pos >> 6);
#pragma unroll
            for (int ks = 0; ks < 6; ++ks)
#pragma unroll
                for (int e = 0; e < 8; ++e) x[ks][e] = x[ks][e] * rstd * qg[ks * 16 + hq * 8 + e];
#pragma unroll
            for (int e = 0; e < 8; ++e) { float sn, cs; fast_sincos(pf_ * rope_freq(e + zq, 1.0f / 8.0f), sn, cs);
                const float a = x[4][e], c = x[5][e]; x[4][e] = a * cs - c * sn; x[5][e] = a * sn + c * cs; }
#pragma unroll
            for (int ks = 0; ks < 6; ++ks) {
#pragma unroll
                for (int e = 0; e < 8; ++e) x[ks][e] *= qscale;
                qf[ks] = __builtin_bit_cast(bf16x8, pack8(x[ks])); }
        }
        KVSrc s; s.ka = (unsigned)WS_KVRAW; s.lda = 2048; s.offa = h * 128; s.kb = (unsigned)WS_KRN; s.ldb = 512; s.offb = h * 32; s.v = (unsigned)WS_KVRAW; s.ldv = 2048; s.offv = h * 128 + 64;
        s.ctx_row0 = MLAT + b * CTX; s.lat_row0 = b * SEQ;
        AC::f32x16 o[2];
        AC::run2_32(lds, p.ws, s, NKEY / 64, qf, o);
        { bf16_t* op = O + (size_t)(qrow0 + l31) * 1024 + h * 64 + 4 * hi;
#pragma unroll
          for (int vb = 0; vb < 2; ++vb)
#pragma unroll
              for (int r4 = 0; r4 < 4; ++r4) { u32x2 w; w.x = cvt_pk_bf16(o[vb][4 * r4 + 0], o[vb][4 * r4 + 1]); w.y = cvt_pk_bf16(o[vb][4 * r4 + 2], o[vb][4 * r4 + 3]);
                  *(u32x2*)(op + vb * 32 + r4 * 8) = w; } }
    }
}
#define XB_TMO      128
#define XB_XCNT(j)  (256  + 64 * (j))
#define XB_XSUB(j)  (1280 + 64 * (j))
#define XB_XGEN(j)  (2304 + 64 * (j))
#define XB_TOP      3328
#define XB_TOPGEN   3392
#define XCD_BAR_WORDS 3456
#define XB_SPIN_CAP (1u << 18)

__device__ __forceinline__ unsigned xb_ld(unsigned* p)              { return __hip_atomic_load(p, __ATOMIC_RELAXED, __HIP_MEMORY_SCOPE_AGENT); }
__device__ __forceinline__ unsigned xb_add(unsigned* p, unsigned v) { return __hip_atomic_fetch_add(p, v, __ATOMIC_RELAXED, __HIP_MEMORY_SCOPE_AGENT); }
__device__ __forceinline__ unsigned xb_xcc_id() { return (unsigned)__builtin_amdgcn_s_getreg((3 << 11) | 20) & 0xFu; }
#define XB_SPIN(cond, bar) do { unsigned _sp = 0; while (cond) { __builtin_amdgcn_s_sleep(1); \
    if ((++_sp & 255u) == 0u) { if (xb_ld(&(bar)[XB_TMO])) break; if (_sp > XB_SPIN_CAP) { atomicAdd(&(bar)[XB_TMO], 1u); break; } } } } while (0)

struct XcdBarrier {
    unsigned* bar; unsigned x;
    volatile LAS unsigned* st;
};

__device__ __forceinline__ XcdBarrier xcd_barrier_post(unsigned* bar, volatile LAS unsigned* st) {
    XcdBarrier b; b.bar = bar; b.x = xb_xcc_id(); b.st = st;
    if (threadIdx.x == 0) (void)xb_add(&bar[XB_XCNT(b.x)], 1u);
    return b;
}
__device__ __forceinline__ void xcd_barrier_complete(unsigned* bar, unsigned x, unsigned& nloc, unsigned& nx) {
    const unsigned G = gridDim.x * gridDim.y * gridDim.z;
    unsigned sum, cnt, mine, sp = 0u;
    for (;;) {
        sum = 0u; cnt = 0u; mine = 0u;
#pragma unroll
        for (unsigned j = 0; j < 16; ++j) { const unsigned c = xb_ld(&bar[XB_XCNT(j)]); sum += c; cnt += (c > 0u) ? 1u : 0u; mine = (j == x) ? c : mine; }
        if (sum == G) break;
        __builtin_amdgcn_s_sleep(1);
        if ((++sp & 255u) == 0u) { if (xb_ld(&bar[XB_TMO])) break; if (sp > XB_SPIN_CAP) { atomicAdd(&bar[XB_TMO], 1u); break; } }
    }
    nloc = mine > 0u ? mine : 1u; nx = cnt > 0u ? cnt : 1u;
}

__device__ __forceinline__ void xcd_barrier(const XcdBarrier& b) {
    asm volatile("s_waitcnt vmcnt(0)" ::: "memory");
    __syncthreads();
    if (threadIdx.x == 0) {
        unsigned* bar = b.bar;
        __builtin_amdgcn_s_waitcnt(0);
        unsigned nloc = b.st[0], nx = b.st[1];
        if (nloc == 0u) { xcd_barrier_complete(bar, b.x, nloc, nx); b.st[0] = nloc; b.st[1] = nx; }
        const unsigned old = xb_add(&bar[XB_XSUB(b.x)], 1u);
        const unsigned gen = old / nloc;
        if (old + 1u == (gen + 1u) * nloc) {
            __builtin_amdgcn_fence(__ATOMIC_RELEASE, "agent");
            asm volatile("s_waitcnt vmcnt(0)" ::: "memory");
            const unsigned og = xb_add(&bar[XB_TOP], 1u);
            const unsigned tg = og / nx;
            if (og + 1u == (tg + 1u) * nx) xb_add(&bar[XB_TOPGEN], 1u);
            else XB_SPIN(xb_ld(&bar[XB_TOPGEN]) == tg, bar);
            __builtin_amdgcn_fence(__ATOMIC_ACQUIRE, "agent");
            xb_add(&bar[XB_XGEN(b.x)], 1u);
            asm volatile("s_waitcnt vmcnt(0)" ::: "memory");
        } else {
            XB_SPIN(xb_ld(&bar[XB_XGEN(b.x)]) == gen, bar);
            __builtin_amdgcn_fence(__ATOMIC_ACQUIRE, "agent");
            asm volatile("s_waitcnt vmcnt(0)" ::: "memory");
        }
    }
    __syncthreads();
}


constexpr int LDS_BYTES = 151680;
constexpr int LDS_BST = LDS_BYTES - 64;
static_assert(XCD_BAR_WORDS * 4 <= 16384, "barrier words do not fit their slot");
static_assert(WS_SS + (size_t)2 * MTOT * 4 <= (size_t)256 * 1024 * 1024, "workspace too large");
constexpr int N_PHASES = 19;

__global__ void __launch_bounds__(NTHR, 2) fwd_megakernel(Params p) {
    extern __shared__ __attribute__((aligned(16))) unsigned char lds_raw[];
    LAS unsigned char* lds = (LAS unsigned char*)lds_raw;
    cg::grid_group grid = cg::this_grid();
    volatile LAS unsigned* bst = (volatile LAS unsigned*)(lds + LDS_BST);
    if (threadIdx.x < 16) bst[threadIdx.x] = 0u;
    __syncthreads();
    XcdBarrier bar = xcd_barrier_post((unsigned*)(p.ws + WS_BAR), bst);
    unsigned char* ws = p.ws;
    const int lo = p.ph_lo, hi = p.ph_hi;
    float* MOD = (float*)(ws + WS_MOD);
    float* HL = p.out; float* HC = (float*)(ws + WS_HC);
    bf16_t* A = (bf16_t*)(ws + WS_A);
#ifndef PROBE_DUP
#define PROBE_DUP -1
#endif
#ifdef ONLY_ATTN
#define IN(k) (((k) == 4 || (k) == 14) && lo <= (k) && (k) < hi)
#else
#define IN(k) (lo <= (k) && (k) < hi)
#endif
#define REP(k) for (int rep_ = 0; rep_ < (((k) == PROBE_DUP || (PROBE_DUP == 200 && ((k) == 2 || (k) == 5 || (k) == 10))) ? 2 : 1); ++rep_)
#define SEAM(k) do { if ((k) + 1 < hi) { if (hi > 1000) grid.sync(); else xcd_barrier(bar); } } while (0)
    #ifndef NO_PREP
    if (IN(0)) { REP(0) prep_phase(p, lds, 0, (int)blockIdx.x, (int)gridDim.x); SEAM(0); }
#endif
    if (PROBE_DUP == 100) { for (int i_ = 0; i_ < 20; ++i_) xcd_barrier(bar); }
    if (IN(1)) { REP(1) norm_phase(p.in[0], p.in[2], p.in[6], MOD, 0, 1, A, MTOT, nullptr, true); SEAM(1); }
    if (IN(2)) { EpiStoreBf16 E; E.O = (bf16_t*)(ws + WS_P); E.ldc = 2048; E.ss = nullptr; E.invn = 0.f; REP(2) run_gemm(lds, A, 1024, (const bf16_t*)(ws + WS_WIN), MTOT, 2048, 1024, E);
                 { int three = MTOT / 256 * 8 - 2 * (int)gridDim.x; if (three < 0 || three >= (int)gridDim.x) three = 0; prep_phase(p, lds, 2, (int)blockIdx.x - three, (int)gridDim.x - three); }
                 SEAM(2); }
    if (IN(3)) { if (PROBE_DUP == 3) prepL0_phase(p, hi < 1000); prepL0_phase(p, false); SEAM(3); }
    #ifndef NO_DIFF
    if (IN(4)) { diffattn_phase(p, lds, PROBE_DUP == 4 ? 2 : 1); SEAM(4); }
#endif
    if (IN(5)) { EpiResid E; E.baseL = p.in[0]; E.baseC = p.in[2]; E.outL = HL; E.outC = HC; E.gate = MOD + 2 * 1024; E.ntbase = true;
                 REP(5) run_gemm(lds, (const bf16_t*)(ws + WS_MIX), 1024, (const bf16_t*)(ws + WS_WOUT), MTOT, 1024, 1024, E);
                 { int two = MTOT / 256 * 4 - (int)gridDim.x; if (two < 0 || two >= (int)gridDim.x) two = 0; prep_phase(p, lds, 1, (int)blockIdx.x - two, (int)gridDim.x - two); }
                 SEAM(5); }
    if (IN(6)) { REP(6) norm_phase(HL, HC, p.in[7], MOD, 3, 4, A, MTOT); SEAM(6); }
    if (IN(7)) { EpiSwiglu E; E.H = (bf16_t*)(ws + WS_HID); E.Hc = (bf16_t*)(ws + WS_HIDC); REP(7) run_gemm(lds, A, 1024, (const bf16_t*)(ws + WS_WGU0), MTOT, 2 * FFN, 1024, E); SEAM(7); }
    if (IN(8)) { { EpiResid E; E.baseL = HL; E.baseC = HC; E.outL = HL; E.outC = HC; E.gate = MOD + 5 * 1024; E.ntbase = false;
                   run_gemm(lds, (const bf16_t*)(ws + WS_HID), FFN, (const bf16_t*)(ws + WS_WD0), MLAT, 1024, FFN, E); }
                 { const int G = (int)gridDim.x, c = (int)blockIdx.x; EpiPart E; E.gate = MOD + (size_t)8 * 6144 + 5 * 1024;
                   { E.part = (float*)(ws + WS_PART); pg8::Gemm g; g.A = (const bf16_t*)(ws + WS_HIDC); g.Bt = (const bf16_t*)(ws + WS_WD0S); g.M = 2 * MCTX; g.N = 2048; g.K = 768; g.lda = 768;
                     SplitSched S; S.G = G; S.c = c; pg8::gemm_phase<EpiPart, SplitSched, true, true>(lds, g, S, E); }
                   { E.part = (float*)(ws + WS_PART) + (size_t)2 * MCTX * 1024; pg8::Gemm g; g.A = (const bf16_t*)(ws + WS_HIDC) + (size_t)2 * MCTX * 768; g.Bt = (const bf16_t*)(ws + WS_WD0S) + (size_t)2 * 1024 * 768;
                     g.M = 2 * MCTX; g.N = 2048; g.K = 640; g.lda = 640;
                     SplitSched S; S.G = G; S.c = (c - 64 % G + G) % G; pg8::gemm_phase<EpiPart, SplitSched, true, true>(lds, g, S, E); } }
                 SEAM(8); }
    const float* MOD1 = MOD + 9 * 6144;
    if (IN(9)) { norm_phase(HL, HC, p.in[6] + 1024, MOD1, 0, 1, A, MTOT, (const float*)(ws + WS_PART)); SEAM(9); }
    if (IN(10)) { EpiLat E; E.O = (bf16_t*)(ws + WS_CQKV); E.gq = p.in[23]; E.gkv = p.in[26]; E.ssq = (float*)(ws + WS_SS); E.ssk = (float*)(ws + WS_SS) + MTOT; run_gemm(lds, A, 1024, (const bf16_t*)(ws + WS_WDQKV), MTOT, 768, 1024, E); SEAM(10); }
    if (IN(12)) REP(12) { { EpiStoreBf16 E; E.O = (bf16_t*)(ws + WS_QRAW); E.ldc = 1536; E.ss = nullptr; E.invn = 0.f; run_gemm(lds, (const bf16_t*)(ws + WS_CQKV), 768, (const bf16_t*)(ws + WS_WUQ), MLAT, 1536, 384, E); }
                  { EpiKV E; E.KV = (bf16_t*)(ws + WS_KVRAW); E.KR = (bf16_t*)(ws + WS_KRN); E.C = (const bf16_t*)(ws + WS_CQKV); E.ssk = (const float*)(ws + WS_SS) + MTOT; E.kg = p.in[29]; run_gemm(lds, (const bf16_t*)(ws + WS_CQKV) + 384, 768, (const bf16_t*)(ws + WS_WUKV), MTOT, 2048, 256, E, (int)gridDim.x / 2); }
                  } if (IN(12)) { SEAM(12); }
    #ifndef NO_MLA
    if (IN(14)) { mla_phase(p, lds, PROBE_DUP == 14 ? 2 : 1); SEAM(14); }
#endif
    if (IN(15)) { EpiResid E; E.baseL = HL; E.baseC = HC; E.outL = HL; E.outC = HC; E.gate = MOD1 + 2 * 1024; E.ntbase = false;
                  run_gemm(lds, A, 1024, (const bf16_t*)(ws + WS_WMO), MLAT, 1024, 1024, E); SEAM(15); }
    if (IN(16)) { REP(16) norm_phase(HL, HC, p.in[7] + 1024, MOD1, 3, 4, A, MLAT); SEAM(16); }
    if (IN(17)) { EpiSwiglu E; E.H = (bf16_t*)(ws + WS_HID); E.Hc = nullptr; run_gemm(lds, A, 1024, (const bf16_t*)(ws + WS_WGU1), MLAT, 2 * FFN, 1024, E); SEAM(17); }
    if (IN(18)) { EpiResid E; E.baseL = HL; E.baseC = HC; E.outL = HL; E.outC = HC; E.gate = MOD1 + 5 * 1024; E.ntbase = false;
                  run_gemm(lds, (const bf16_t*)(ws + WS_HID), FFN, (const bf16_t*)(ws + WS_WD1), MLAT, 1024, FFN, E); }
#undef IN
#undef SEAM
#undef REP
}

extern "C" void kernel_launch(void* const* d_in, const int* in_sizes, int n_in, void* d_out, int out_size, void* d_ws, size_t ws_size, hipStream_t stream) {
    static int grid = 0;
    if (grid == 0) {
        if (n_in != 31 || out_size != MLAT * DM || ws_size < WS_END) { fprintf(stderr, "kernel_launch: unexpected shapes (n_in %d out %d ws %zu)\n", n_in, out_size, ws_size); grid = -1; return; }
        int dev = 0, cus = 0, per_cu = 0;
        hipGetDevice(&dev);
        hipDeviceGetAttribute(&cus, hipDeviceAttributeMultiprocessorCount, dev);
        if (hipFuncSetAttribute((const void*)fwd_megakernel, hipFuncAttributeMaxDynamicSharedMemorySize, LDS_BYTES) != hipSuccess) { fprintf(stderr, "kernel_launch: hipFuncSetAttribute failed\n"); grid = -1; return; }
        if (hipOccupancyMaxActiveBlocksPerMultiprocessor(&per_cu, (const void*)fwd_megakernel, NTHR, LDS_BYTES) != hipSuccess || per_cu < 1) { fprintf(stderr, "kernel_launch: occupancy query gave %d\n", per_cu); per_cu = 1; }
        (void)hipGetLastError();
        grid = cus * 1;
        if (grid % 8 != 0 || grid <= 0) { fprintf(stderr, "kernel_launch: odd CU count %d\n", cus); }
    }
    if (grid < 0) return;
    Params p{};
    for (int i = 0; i < 31; ++i) p.in[i] = (const float*)d_in[i];
    p.out = (float*)d_out; p.ws = (unsigned char*)d_ws;
    if (hipMemsetAsync((char*)d_ws + WS_BAR, 0, ZERO_BYTES, stream) != hipSuccess) { fprintf(stderr, "kernel_launch: memset failed\n"); return; }
#if ONE_LAUNCH
    p.ph_lo = 0; p.ph_hi = N_PHASES;
    void* args[] = {&p};
    hipError_t e = hipLaunchCooperativeKernel((const void*)fwd_megakernel, dim3(grid), dim3(NTHR), args, LDS_BYTES, stream);
    if (e != hipSuccess) fprintf(stderr, "cooperative launch failed: %s (grid %d)\n", hipGetErrorString(e), grid);
#else
    for (int ph = 0; ph < N_PHASES; ++ph) { p.ph_lo = ph; p.ph_hi = ph + 1; hipLaunchKernelGGL(fwd_megakernel, dim3(grid), dim3(NTHR), LDS_BYTES, stream, p); }
#endif
}
```
